# Optimizing an MI355X kernel written in HIP

```python
import math
import jax, jax.numpy as jnp
from jax import lax
import numpy as np

D_MODEL = 1024
BATCH = 4
SEQ = 4096
DEPTH = 4

N_MIXERS = 2
N_MLA = (DEPTH + 1) // 2
N_SSD = DEPTH // 2
N_SUB = 3
EPS = 1e-6

D_FF = 2816

MLA_HEADS = 16
Q_LORA = 384
KV_LORA = 256
QK_NOPE = 64
QK_ROPE = 32
QK_HEAD = QK_NOPE + QK_ROPE
V_HEAD = 64
MLA_A_DIM = Q_LORA + KV_LORA + QK_ROPE
ROPE_THETA = 10000.0
Q_BLOCK = 128
MAX_POS_OFFSET = 1024

SSD_EXPAND = 2
D_INNER = SSD_EXPAND * D_MODEL
SSD_HEAD_DIM = 64
SSD_HEADS = D_INNER // SSD_HEAD_DIM
SSD_GROUPS = 4
SSD_STATE = 128
CONV_WIDTH = 4
CHUNK = 128
CONV_DIM = D_INNER + 2 * SSD_GROUPS * SSD_STATE
IN_PROJ_DIM = 2 * D_INNER + 2 * SSD_GROUPS * SSD_STATE + SSD_HEADS
DT_MIN = 0.001
DT_MAX = 0.1

kernel_name = 'hybrid_mla_ssd_macaron_adaln'


def rms_norm(x, gain):
    xf = x.astype(jnp.float32)
    y = xf * lax.rsqrt(jnp.mean(xf * xf, axis=-1, keepdims=True) + EPS)
    return (y * gain.astype(jnp.float32)).astype(x.dtype)


def modulate(x, gain, mod):
    return rms_norm(x, gain) * (1 + mod[:, None, 1]) + mod[:, None, 0]


def swiglu(h, w_gu, w_down):
    g, u = jnp.split(h @ w_gu, 2, axis=-1)
    return (jax.nn.silu(g) * u) @ w_down


def rope_tables(positions):
    inv = 1.0 / (ROPE_THETA ** (jnp.arange(0, QK_ROPE, 2, dtype=jnp.float32) / QK_ROPE))
    ang = positions.astype(jnp.float32)[..., None] * inv
    return jnp.cos(ang), jnp.sin(ang)


def apply_rope(x, cos, sin):
    x1, x2 = jnp.split(x, 2, axis=-1)
    cos = cos[:, :, None].astype(x.dtype)
    sin = sin[:, :, None].astype(x.dtype)
    return jnp.concatenate([x1 * cos - x2 * sin, x1 * sin + x2 * cos], axis=-1)


def causal_block_attention(q, k, v):
    Bn, S, H, Dh = q.shape
    Dv = v.shape[-1]
    nb = S // Q_BLOCK
    scale = Dh ** -0.5
    qb = q.reshape(Bn, nb, Q_BLOCK, H, Dh).transpose(1, 0, 3, 2, 4)
    kt = k.transpose(0, 2, 1, 3)
    vt = v.transpose(0, 2, 1, 3)
    k_pos = jnp.arange(S)

    def one_block(args):
        q_blk, i = args
        s = jnp.einsum('bhqd,bhkd->bhqk', q_blk, kt, preferred_element_type=jnp.float32) * scale
        q_pos = i * Q_BLOCK + jnp.arange(Q_BLOCK)
        s = jnp.where(k_pos[None, :] <= q_pos[:, None], s, -jnp.inf)
        p = jax.nn.softmax(s, axis=-1).astype(vt.dtype)
        return jnp.einsum('bhqk,bhkd->bhqd', p, vt)

    o = lax.map(one_block, (qb, jnp.arange(nb)))
    return o.transpose(1, 0, 3, 2, 4).reshape(Bn, S, H, Dv)


def mla_mixer(h, cos, sin, w_a, q_a_gain, kv_a_gain, w_qb, w_kvb, q_gain, k_gain, w_o):
    Bn, S, _ = h.shape
    q_lat, kv_lat, k_rope = jnp.split(h @ w_a, [Q_LORA, Q_LORA + KV_LORA], axis=-1)
    q = (rms_norm(q_lat, q_a_gain) @ w_qb).reshape(Bn, S, MLA_HEADS, QK_HEAD)
    kv = (rms_norm(kv_lat, kv_a_gain) @ w_kvb).reshape(Bn, S, MLA_HEADS, QK_NOPE + V_HEAD)
    k_nope, v = jnp.split(kv, [QK_NOPE], axis=-1)
    k_rope = jnp.broadcast_to(k_rope[:, :, None, :], (Bn, S, MLA_HEADS, QK_ROPE))
    k = jnp.concatenate([k_nope, k_rope], axis=-1)
    q = rms_norm(q, q_gain)
    k = rms_norm(k, k_gain)
    q = jnp.concatenate([q[..., :QK_NOPE], apply_rope(q[..., QK_NOPE:], cos, sin)], axis=-1)
    k = jnp.concatenate([k[..., :QK_NOPE], apply_rope(k[..., QK_NOPE:], cos, sin)], axis=-1)
    o = causal_block_attention(q, k, v)
    return o.reshape(Bn, S, MLA_HEADS * V_HEAD) @ w_o


def causal_depthwise_conv(u, w, b):
    out = lax.conv_general_dilated(
        u, w[:, None, :].astype(u.dtype), window_strides=(1,), padding=[(CONV_WIDTH - 1, 0)],
        dimension_numbers=('NWC', 'WIO', 'NWC'), feature_group_count=u.shape[-1])
    return out + b


def ssd_chunked_scan(x, dt, A, Bm, Cm):
    Bn, S, H, P = x.shape
    G, N = Bm.shape[2], Bm.shape[3]
    K = H // G
    nc = S // CHUNK
    f32 = jnp.float32
    xdt = (x.astype(f32) * dt[..., None]).reshape(Bn, nc, CHUNK, G, K, P)
    a = (dt * A).reshape(Bn, nc, CHUNK, G, K).transpose(0, 1, 3, 4, 2)
    Bc = Bm.astype(f32).reshape(Bn, nc, CHUNK, G, N)
    Cc = Cm.astype(f32).reshape(Bn, nc, CHUNK, G, N)
    a_cum = jnp.cumsum(a, axis=-1)
    seg = a_cum[..., :, None] - a_cum[..., None, :]
    causal = jnp.tril(jnp.ones((CHUNK, CHUNK), dtype=bool))
    decay_ls = jnp.exp(jnp.where(causal, seg, -jnp.inf))
    cb = jnp.einsum('bclgn,bcsgn->bcgls', Cc, Bc)
    y_diag = jnp.einsum('bcgls,bcgkls,bcsgkp->bclgkp', cb, decay_ls, xdt)
    decay_to_end = jnp.exp(a_cum[..., -1:] - a_cum)
    states = jnp.einsum('bclgn,bcgkl,bclgkp->bcgkpn', Bc, decay_to_end, xdt)
    chunk_decay = jnp.exp(a_cum[..., -1])

    def step(carry, inp):
        st, dec = inp
        return carry * dec[..., None, None] + st, carry

    init = jnp.zeros((Bn, G, K, P, N), f32)
    _, prev = lax.scan(step, init, (states.transpose(1, 0, 2, 3, 4, 5), chunk_decay.transpose(1, 0, 2, 3)))
    prev = prev.transpose(1, 0, 2, 3, 4, 5)
    y_off = jnp.einsum('bclgn,bcgkpn,bcgkl->bclgkp', Cc, prev, jnp.exp(a_cum))
    return (y_diag + y_off).reshape(Bn, S, H, P).astype(x.dtype)


def ssd_mixer(h, w_in, conv_w, conv_b, dt_bias, a_log, d_skip, norm_gain, w_out):
    Bn, S, _ = h.shape
    z, xbc, dt = jnp.split(h @ w_in, [D_INNER, D_INNER + CONV_DIM], axis=-1)
    xbc = jax.nn.silu(causal_depthwise_conv(xbc, conv_w, conv_b))
    xs, Bm, Cm = jnp.split(xbc, [D_INNER, D_INNER + SSD_GROUPS * SSD_STATE], axis=-1)
    xs = xs.reshape(Bn, S, SSD_HEADS, SSD_HEAD_DIM)
    Bm = Bm.reshape(Bn, S, SSD_GROUPS, SSD_STATE)
    Cm = Cm.reshape(Bn, S, SSD_GROUPS, SSD_STATE)
    dt = jax.nn.softplus(dt.astype(jnp.float32) + dt_bias.astype(jnp.float32))
    A = -jnp.exp(a_log.astype(jnp.float32))
    y = ssd_chunked_scan(xs, dt, A, Bm, Cm)
    y = (y + d_skip[:, None] * xs).reshape(Bn, S, D_INNER)
    g = (y * jax.nn.silu(z)).reshape(Bn, S, SSD_GROUPS, D_INNER // SSD_GROUPS)
    g = rms_norm(g, norm_gain.reshape(SSD_GROUPS, D_INNER // SSD_GROUPS)).reshape(Bn, S, D_INNER)
    return g @ w_out


def setup_inputs(seed: int = 0) -> dict:
    key = jax.random.key(seed)
    ks = jax.random.split(key, 32)
    f32 = jnp.float32

    def nrm(k, shape, fan_in, mult=1.0):
        return jax.random.normal(k, shape, f32) * (mult * fan_in ** -0.5)

    def gain(k, shape):
        return 1.0 + 0.02 * jax.random.normal(k, shape, f32)

    x = jax.random.normal(ks[0], (BATCH, SEQ, D_MODEL), f32)
    c = jax.random.normal(ks[1], (BATCH, D_MODEL), f32)
    positions = (jax.random.randint(ks[2], (BATCH, 1), 0, MAX_POS_OFFSET, dtype=jnp.int32)
                 + jnp.arange(SEQ, dtype=jnp.int32)[None, :])
    norm_gain = gain(ks[3], (DEPTH, N_SUB, D_MODEL))
    ada_w = nrm(ks[4], (DEPTH, D_MODEL, N_SUB * 3 * D_MODEL), D_MODEL, 0.5)
    ada_b = 0.02 * jax.random.normal(ks[5], (DEPTH, N_SUB * 3 * D_MODEL), f32)
    ffn_w_gu = nrm(ks[6], (DEPTH, 2, D_MODEL, 2 * D_FF), D_MODEL)
    ffn_w_down = nrm(ks[7], (DEPTH, 2, D_FF, D_MODEL), D_FF)
    mla_w_a = nrm(ks[8], (N_MLA, D_MODEL, MLA_A_DIM), D_MODEL)
    mla_q_a_gain = gain(ks[9], (N_MLA, Q_LORA))
    mla_kv_a_gain = gain(ks[10], (N_MLA, KV_LORA))
    mla_w_qb = nrm(ks[11], (N_MLA, Q_LORA, MLA_HEADS * QK_HEAD), Q_LORA)
    mla_w_kvb = nrm(ks[12], (N_MLA, KV_LORA, MLA_HEADS * (QK_NOPE + V_HEAD)), KV_LORA)
    mla_q_gain = gain(ks[13], (N_MLA, QK_HEAD))
    mla_k_gain = gain(ks[14], (N_MLA, QK_HEAD))
    mla_w_o = nrm(ks[15], (N_MLA, MLA_HEADS * V_HEAD, D_MODEL), MLA_HEADS * V_HEAD)
    ssd_w_in = nrm(ks[16], (N_SSD, D_MODEL, IN_PROJ_DIM), D_MODEL)
    ssd_conv_w = nrm(ks[17], (N_SSD, CONV_WIDTH, CONV_DIM), CONV_WIDTH)
    ssd_conv_b = 0.02 * jax.random.normal(ks[18], (N_SSD, CONV_DIM), f32)
    dt0 = jnp.exp(jax.random.uniform(ks[19], (N_SSD, SSD_HEADS), f32, math.log(DT_MIN), math.log(DT_MAX)))
    ssd_dt_bias = dt0 + jnp.log(-jnp.expm1(-dt0))
    ssd_a_log = jnp.log(jax.random.uniform(ks[20], (N_SSD, SSD_HEADS), f32, 1.0, 16.0))
    ssd_d = gain(ks[21], (N_SSD, SSD_HEADS))
    ssd_norm_gain = gain(ks[22], (N_SSD, D_INNER))
    ssd_w_out = nrm(ks[23], (N_SSD, D_INNER, D_MODEL), D_INNER)
    return {
        'x': x, 'c': c, 'positions': positions,
        'norm_gain': norm_gain, 'ada_w': ada_w, 'ada_b': ada_b,
        'ffn_w_gu': ffn_w_gu, 'ffn_w_down': ffn_w_down,
        'mla_w_a': mla_w_a, 'mla_q_a_gain': mla_q_a_gain, 'mla_kv_a_gain': mla_kv_a_gain,
        'mla_w_qb': mla_w_qb, 'mla_w_kvb': mla_w_kvb, 'mla_q_gain': mla_q_gain,
        'mla_k_gain': mla_k_gain, 'mla_w_o': mla_w_o,
        'ssd_w_in': ssd_w_in, 'ssd_conv_w': ssd_conv_w, 'ssd_conv_b': ssd_conv_b,
        'ssd_dt_bias': ssd_dt_bias, 'ssd_a_log': ssd_a_log, 'ssd_d': ssd_d,
        'ssd_norm_gain': ssd_norm_gain, 'ssd_w_out': ssd_w_out,
    }


def reference(x, c, positions, norm_gain, ada_w, ada_b, ffn_w_gu, ffn_w_down,
              mla_w_a, mla_q_a_gain, mla_kv_a_gain, mla_w_qb, mla_w_kvb, mla_q_gain,
              mla_k_gain, mla_w_o, ssd_w_in, ssd_conv_w, ssd_conv_b, ssd_dt_bias,
              ssd_a_log, ssd_d, ssd_norm_gain, ssd_w_out):
    Bn = x.shape[0]
    cos, sin = rope_tables(positions)
    mods = jnp.einsum('bd,lde->lbe', jax.nn.silu(c), ada_w) + ada_b[:, None, :]
    mods = mods.reshape(DEPTH, Bn, N_SUB, 3, D_MODEL)
    for i in range(DEPTH):
        m = mods[i]
        j = i // N_MIXERS
        h = modulate(x, norm_gain[i, 0], m[:, 0])
        x = x + 0.5 * m[:, None, 0, 2] * swiglu(h, ffn_w_gu[i, 0], ffn_w_down[i, 0])
        h = modulate(x, norm_gain[i, 1], m[:, 1])
        if i % N_MIXERS == 0:
            y = mla_mixer(h, cos, sin, mla_w_a[j], mla_q_a_gain[j], mla_kv_a_gain[j], mla_w_qb[j],
                          mla_w_kvb[j], mla_q_gain[j], mla_k_gain[j], mla_w_o[j])
        else:
            y = ssd_mixer(h, ssd_w_in[j], ssd_conv_w[j], ssd_conv_b[j], ssd_dt_bias[j], ssd_a_log[j],
                          ssd_d[j], ssd_norm_gain[j], ssd_w_out[j])
        x = x + m[:, None, 1, 2] * y
        h = modulate(x, norm_gain[i, 2], m[:, 2])
        x = x + 0.5 * m[:, None, 2, 2] * swiglu(h, ffn_w_gu[i, 1], ffn_w_down[i, 1])
    return x
```

```cpp
#include <hip/hip_runtime.h>
#include <hip/hip_cooperative_groups.h>
#include <cstdio>
#include <cstdint>
#include <cmath>
namespace cg = cooperative_groups;

#define LAS __attribute__((address_space(3)))
#define DI __device__ __forceinline__
typedef unsigned short bf16_t;
typedef short bf16x8 __attribute__((ext_vector_type(8)));
typedef short s16x4 __attribute__((ext_vector_type(4)));
typedef float f32x4 __attribute__((ext_vector_type(4)));
typedef float f32x2 __attribute__((ext_vector_type(2)));
typedef float f32x16 __attribute__((ext_vector_type(16)));
typedef unsigned u32x4 __attribute__((ext_vector_type(4)));
typedef unsigned u32x2 __attribute__((ext_vector_type(2)));
typedef __bf16 bf16x2_t __attribute__((ext_vector_type(2)));
typedef LAS unsigned char* ldsp;

constexpr int DM = 1024, NBATCH = 4, SEQ = 4096, T = NBATCH * SEQ, DEPTH = 4;
constexpr int DFF = 2816;
constexpr int HEADS = 16, QL = 384, KVL = 256, QKH = 96, ADIM = 672, ADIMP = 768;
constexpr int DIN = 2048, SSDH = 32, INP = 5152, INPP = 5376, ZXW = 5120, CONVD = 3072;
constexpr float EPS = 1e-6f;
constexpr float QSCALE = 0.10206207261596577f * 1.4426950408889634f;

constexpr size_t MiB = 1u << 20;
constexpr size_t WS_CTL = 0;
constexpr size_t WS_MODS = 1 * MiB;
constexpr size_t WS_ROWSS = 4 * MiB;
constexpr size_t WS_BIAS = 2 * MiB;
constexpr int NBIAS = 5632;
static_assert(WS_BIAS + (size_t)12 * 4 * NBIAS * 4 <= WS_ROWSS && WS_ROWSS + (size_t)T * 16 * 4 <= 6 * MiB, "ws map");
constexpr size_t WS_WGU = 6 * MiB;
constexpr size_t SZ_WGU = (size_t)5632 * 1024 * 2;
constexpr size_t WS_WDN = WS_WGU + 8 * SZ_WGU;
constexpr size_t SZ_WDN = (size_t)1024 * 2816 * 2;
constexpr size_t WS_WA = WS_WDN + 8 * SZ_WDN;
constexpr size_t SZ_WA = (size_t)ADIMP * 1024 * 2;
constexpr size_t WS_WQB = WS_WA + 2 * SZ_WA;
constexpr size_t SZ_WQB = (size_t)1536 * 384 * 2;
constexpr size_t WS_WKVB = WS_WQB + 2 * SZ_WQB;
constexpr size_t SZ_WKVB = (size_t)2048 * 256 * 2;
constexpr size_t WS_WO = WS_WKVB + 2 * SZ_WKVB;
constexpr size_t SZ_WO = (size_t)1024 * 1024 * 2;
constexpr size_t WS_WIN = WS_WO + 2 * SZ_WO;
constexpr size_t SZ_WIN = (size_t)INPP * 1024 * 2;
constexpr size_t WS_WOUT = WS_WIN + 2 * SZ_WIN;
constexpr size_t SZ_WOUT = (size_t)1024 * 2048 * 2;
constexpr size_t WS_H = WS_WOUT + 2 * SZ_WOUT;
constexpr size_t WS_SCR = WS_H + (size_t)T * 1024 * 2;
constexpr size_t WS_ACT = WS_SCR;
constexpr size_t WS_AOUT = WS_SCR;
constexpr size_t WS_QRAW = WS_AOUT + (size_t)T * ADIMP * 2;
constexpr size_t WS_KVRAW = WS_QRAW + (size_t)T * 1536 * 2;
constexpr size_t WS_QB = WS_KVRAW + (size_t)T * 2048 * 2;
constexpr size_t WS_KB = WS_QB + (size_t)T * 1536 * 2;
constexpr size_t WS_VT = WS_KB + (size_t)T * 1536 * 2;
constexpr size_t WS_O = WS_VT + (size_t)T * 1024 * 2;
constexpr size_t WS_MLA_END = WS_O + (size_t)T * 1024 * 2;
constexpr size_t WS_ZX = WS_SCR;
constexpr size_t WS_DTRAW = WS_ZX + (size_t)T * ZXW * 2;
constexpr size_t WS_XT = WS_DTRAW + (size_t)T * 32 * 4;
constexpr size_t WS_GN = WS_XT;
constexpr size_t WS_BC = WS_XT + (size_t)T * 2048 * 2;
constexpr size_t WS_CC = WS_BC + (size_t)T * 512 * 2;
constexpr size_t WS_BT = WS_CC + (size_t)T * 512 * 2;
constexpr size_t WS_Y = WS_BT + (size_t)T * 512 * 2;
constexpr size_t WS_SSD_END = WS_Y + (size_t)T * 2048 * 2;
constexpr size_t WS_END = (WS_SSD_END > WS_MLA_END ? WS_SSD_END : WS_MLA_END);

constexpr int LDS_BYTES = 147456;
constexpr bool FUSE_NORM = false;
#ifndef DUP
#define DUP 0
#endif
#define REP(mask) _Pragma("unroll 1") for (int rep_ = 0; rep_ < ((DUP & (mask)) ? 2 : 1); ++rep_)

struct Params {
    const float* x; const float* c; const int* pos; const float* norm_gain; const float* ada_w; const float* ada_b;
    const float* ffn_w_gu; const float* ffn_w_down;
    const float* mla_w_a; const float* mla_q_a_gain; const float* mla_kv_a_gain; const float* mla_w_qb; const float* mla_w_kvb;
    const float* mla_q_gain; const float* mla_k_gain; const float* mla_w_o;
    const float* ssd_w_in; const float* ssd_conv_w; const float* ssd_conv_b; const float* ssd_dt_bias; const float* ssd_a_log;
    const float* ssd_d; const float* ssd_norm_gain; const float* ssd_w_out;
    float* out; unsigned char* ws;
};

typedef const __attribute__((address_space(4))) Params* PPtr;
#define FRESH(p) asm volatile("" : "+s"(p))
DI unsigned pk2(float lo, float hi) { f32x2 v = {lo, hi}; bf16x2_t b = __builtin_convertvector(v, bf16x2_t); return __builtin_bit_cast(unsigned, b); }
DI bf16_t f2bf(float v) { return (bf16_t)(pk2(v, 0.f) & 0xffffu); }
DI float bflo(unsigned w) { return __uint_as_float(w << 16); }
DI float bfhi(unsigned w) { return __uint_as_float(w & 0xffff0000u); }
DI int opaque_tid() { int t = threadIdx.x; asm volatile("" : "+v"(t)); return t; }
DI int opaque_bid() { int t = blockIdx.x; asm volatile("" : "+s"(t)); return t; }
#define PHASE_IDS() const int tid = opaque_tid(), lane = tid & 63, wave = __builtin_amdgcn_readfirstlane(tid >> 6); (void)lane; (void)wave
#define LDS_BARRIER() do { asm volatile("s_waitcnt lgkmcnt(0)" ::: "memory"); __builtin_amdgcn_s_barrier(); asm volatile("" ::: "memory"); } while (0)
DI float wave_sum(float v) {
#pragma unroll
    for (int o = 1; o < 64; o <<= 1) v += __shfl_xor(v, o);
    return v;
}
DI float silu_f(float g) { return g * __builtin_amdgcn_rcpf(1.0f + __expf(-g)); }
DI int crow(int reg, int h) { return (reg & 3) + 8 * (reg >> 2) + 4 * h; }
#define MFMA32(a, b, c) __builtin_amdgcn_mfma_f32_32x32x16_bf16((a), (b), (c), 0, 0, 0)
DI bf16x8 pack8(const f32x16& x, int s) {
    u32x4 p;
    p[0] = pk2(x[8 * s + 0], x[8 * s + 1]); p[1] = pk2(x[8 * s + 2], x[8 * s + 3]);
    p[2] = pk2(x[8 * s + 4], x[8 * s + 5]); p[3] = pk2(x[8 * s + 6], x[8 * s + 7]);
    return __builtin_bit_cast(bf16x8, p);
}

namespace pg8 {
constexpr int BM = 256, BK = 64, HALF = 128, HTB = HALF * BK * 2, STAGE_BYTES = 8 * HTB, NXCD = 8, WGM = 8;
DI int lds_byte(int r, int c) { const int st = (r >> 4) * 2 + (c >> 5), rr = r & 15, cc = c & 31, ob = rr * 64 + cc * 2; return st * 1024 + (ob ^ (((ob >> 9) & 1) << 5)); }
DI void stage_rc(int b, int& R, int& C) { const int st = b / 1024, sb = b % 1024, swz = sb ^ (((sb >> 9) & 1) << 5); R = (st >> 1) * 16 + swz / 64; C = (st & 1) * 32 + (swz % 64) / 2; }
DI int perm32(int rho) { const int n = rho >> 4, i = rho & 15; return 8 * (i >> 2) + 4 * n + (i & 3); }

struct Unit { int pm, pn; };
struct Gemm { const bf16_t* A; const bf16_t* Bt; int M, N, K, lda; };

struct StaticOrder {
    int nM, nN, nwg, G, c;
    DI void init(int M, int N, int G_, int c_) { nM = M / BM; nN = N / BM; nwg = nM * nN; G = G_; c = c_; }
    DI bool next(int i, Unit& u) const {
        const long L = (long)i * G + c; if (L >= nwg) return false;
        int wgid = (int)L; { const int q = nwg / NXCD, r = nwg % NXCD, xcd = wgid % NXCD, off = wgid / NXCD; wgid = (xcd < r ? xcd * (q + 1) : r * (q + 1) + (xcd - r) * q) + off; }
        const int nig = WGM * nN, gid = wgid / nig, fm = gid * WGM, gsz = (nM - fm) < WGM ? (nM - fm) : WGM;
        u.pm = fm + ((wgid % nig) % gsz); u.pn = (wgid % nig) / gsz; return true;
    }
};

struct EpiSwiGLU {
    static constexpr bool PERM = true;
    bf16_t* O;
    DI void operator()(const f32x4 (&acc)[2][2][4][2], const Unit& u, int wr, int wc, int fr, int fq) const {
        const int row0 = u.pm * BM + wr * 64 + fr; const int col0 = (u.pn * BM + wc * 32 + 8 * fq) >> 1;
#pragma unroll
        for (int ai = 0; ai < 2; ++ai)
#pragma unroll
            for (int m = 0; m < 4; ++m) { bf16_t* rowp = O + (size_t)(row0 + ai * HALF + m * 16) * DFF + col0;
#pragma unroll
                for (int bj = 0; bj < 2; ++bj) { const f32x4 v0 = acc[ai][bj][m][0], v1 = acc[ai][bj][m][1];
                    u32x2 w; w.x = pk2(silu_f(v0[0]) * v0[1], silu_f(v0[2]) * v0[3]); w.y = pk2(silu_f(v1[0]) * v1[1], silu_f(v1[2]) * v1[3]);
                    *(u32x2*)(rowp + bj * 64) = w; } }
    }
};
struct EpiStore {
    static constexpr bool PERM = true;
    bf16_t* O; int ldc; int nbf; float* dt;
    DI void operator()(const f32x4 (&acc)[2][2][4][2], const Unit& u, int wr, int wc, int fr, int fq) const {
        const int row0 = u.pm * BM + wr * 64 + fr; const int c0 = u.pn * BM + wc * 32 + 8 * fq;
#pragma unroll
        for (int ai = 0; ai < 2; ++ai)
#pragma unroll
            for (int m = 0; m < 4; ++m) { const int row = row0 + ai * HALF + m * 16;
#pragma unroll
                for (int bj = 0; bj < 2; ++bj) { const int c = c0 + bj * HALF; const f32x4 v0 = acc[ai][bj][m][0], v1 = acc[ai][bj][m][1];
                    if (c < nbf) { u32x4 w; w.x = pk2(v0[0], v0[1]); w.y = pk2(v0[2], v0[3]); w.z = pk2(v1[0], v1[1]); w.w = pk2(v1[2], v1[3]);
                        *(u32x4*)(O + (size_t)row * ldc + c) = w; }
                    else if (dt != nullptr && c < nbf + 32) { float* d = dt + (size_t)row * 32 + (c - nbf); *(f32x4*)d = v0; *(f32x4*)(d + 4) = v1; } } }
    }
};
struct EpiRes {
    static constexpr bool PERM = false;
    const float* xin; float* xout; const float* gate; bf16_t* xb; const float* gain_n; const float* mods_n; float* slots; unsigned* cnt; float gs; int fused; unsigned expect; int pad_;
    DI void operator()(f32x4 (&acc)[2][2][4][2], const Unit& u, int wr, int wc, int fr, int fq) const {
        const int col0 = u.pn * BM + wc * 32 + 4 * fq; const float* g = gate + (size_t)(u.pm >> 4) * 9216;
        {
            f32x4 gv[2][2];
#pragma unroll
            for (int bj = 0; bj < 2; ++bj)
#pragma unroll
                for (int n = 0; n < 2; ++n) gv[bj][n] = *(const f32x4*)(g + col0 + bj * HALF + n * 16) * gs;
#pragma unroll
            for (int ai = 0; ai < 2; ++ai)
#pragma unroll
                for (int m = 0; m < 4; ++m) { const int row = u.pm * BM + ai * HALF + wr * 64 + m * 16 + fr; const size_t off = (size_t)row * DM + col0;
                    float sq = 0.f;
#pragma unroll
                    for (int bj = 0; bj < 2; ++bj)
#pragma unroll
                        for (int n = 0; n < 2; ++n) { const f32x4 xi = *(const f32x4*)(xin + off + bj * HALF + n * 16);
                            const f32x4 o = xi + gv[bj][n] * acc[ai][bj][m][n];
                            if (!fused) *(f32x4*)(xout + off + bj * HALF + n * 16) = o;
                            acc[ai][bj][m][n] = o;
                            sq += (o[0] * o[0] + o[1] * o[1]) + (o[2] * o[2] + o[3] * o[3]); }
                    if (fused) { sq += __shfl_xor(sq, 16); sq += __shfl_xor(sq, 32);
                        if (fq == 0) __hip_atomic_store(slots + (size_t)row * 16 + u.pn * 4 + wc, sq, __ATOMIC_RELAXED, __HIP_MEMORY_SCOPE_AGENT); }
                    if (m & 1) asm volatile("" ::: "memory"); }
        }
        if (!fused) return;
        asm volatile("s_waitcnt vmcnt(0)" ::: "memory");
        unsigned* c = cnt + 64 * u.pm;
        if (fr == 0 && fq == 0) __hip_atomic_fetch_add(c, 1u, __ATOMIC_RELAXED, __HIP_MEMORY_SCOPE_AGENT);
#pragma unroll
        for (int ai = 0; ai < 2; ++ai)
#pragma unroll
            for (int m = 0; m < 4; ++m) { const size_t off = (size_t)(u.pm * BM + ai * HALF + wr * 64 + m * 16 + fr) * DM + col0;
#pragma unroll
                for (int bj = 0; bj < 2; ++bj)
#pragma unroll
                    for (int n = 0; n < 2; ++n) *(f32x4*)(xout + off + bj * HALF + n * 16) = acc[ai][bj][m][n]; }
        if (fr == 0 && fq == 0) {
            unsigned it = 0;
            while (__hip_atomic_load(c, __ATOMIC_RELAXED, __HIP_MEMORY_SCOPE_AGENT) < expect && ++it < (1u << 21)) __builtin_amdgcn_s_sleep(2);
        }
        asm volatile("" ::: "memory");
        const float* sh = mods_n + (size_t)(u.pm >> 4) * 9216;
        f32x4 gsc[2][2], shv[2][2];
#pragma unroll
        for (int bj = 0; bj < 2; ++bj)
#pragma unroll
            for (int n = 0; n < 2; ++n) { const int c4 = col0 + bj * HALF + n * 16;
                gsc[bj][n] = *(const f32x4*)(gain_n + c4) * (*(const f32x4*)(sh + 1024 + c4) + 1.0f); shv[bj][n] = *(const f32x4*)(sh + c4); }
#pragma unroll
        for (int ai = 0; ai < 2; ++ai)
#pragma unroll
            for (int m = 0; m < 4; ++m) { const int row = u.pm * BM + ai * HALF + wr * 64 + m * 16 + fr; const size_t off = (size_t)row * DM + col0;
                const float* sp = slots + (size_t)row * 16 + 4 * fq;
                float t = (__hip_atomic_load(sp, __ATOMIC_RELAXED, __HIP_MEMORY_SCOPE_AGENT) + __hip_atomic_load(sp + 1, __ATOMIC_RELAXED, __HIP_MEMORY_SCOPE_AGENT))
                        + (__hip_atomic_load(sp + 2, __ATOMIC_RELAXED, __HIP_MEMORY_SCOPE_AGENT) + __hip_atomic_load(sp + 3, __ATOMIC_RELAXED, __HIP_MEMORY_SCOPE_AGENT));
                t += __shfl_xor(t, 16); t += __shfl_xor(t, 32);
                const float rs = rsqrtf(t * (1.0f / DM) + EPS);
#pragma unroll
                for (int bj = 0; bj < 2; ++bj)
#pragma unroll
                    for (int n = 0; n < 2; ++n) { const f32x4 hv = acc[ai][bj][m][n] * rs * gsc[bj][n] + shv[bj][n];
                        u32x2 w; w.x = pk2(hv[0], hv[1]); w.y = pk2(hv[2], hv[3]); *(u32x2*)(xb + off + bj * HALF + n * 16) = w; } }
    }
};

template <class Epi, bool ALIGN_EPI = true>
DI void gemm_phase(ldsp lds, const Gemm g, const StaticOrder S, const Epi E) {
    const int tid = opaque_tid(), wid = __builtin_amdgcn_readfirstlane(tid >> 6), lane = tid & 63, wr = wid >> 2, wc = wid & 3, fr = lane & 15, fq = lane >> 4;
    const int K = g.K, nt = K / BK, lda = g.lda;
    unsigned voffA[2], voffB[2];
#pragma unroll
    for (int i = 0; i < 2; ++i) { int R, C; stage_rc(tid * 16 + i * 8192, R, C); const int Rb = Epi::PERM ? ((R & ~31) + perm32(R & 31)) : R;
        voffA[i] = (unsigned)(R * lda + C) * 2u; voffB[i] = (unsigned)(Rb * K + C) * 2u; }
    const size_t kstep = (size_t)(BK * 2);
    const size_t hstepA = (size_t)HALF * lda * 2, hstepB = (size_t)HALF * K * 2;
    const size_t tstepA = 2 * hstepA, tstepB = 2 * hstepB;
    const unsigned ldsw = (unsigned)wid * 1024u;
    const int aoff = lds_byte(wr * 64 + fr, fq * 8), boff = lds_byte(wc * 32 + fr, fq * 8);
#define PG8_SA(b, h) (((b) * 2 + (h)) * HTB)
#define PG8_SB(b, h) ((4 + (b) * 2 + (h)) * HTB)
#define PG8_STAGE(bufoff, gbase, voff) do { _Pragma("unroll") for (int _i = 0; _i < 2; ++_i) \
        __builtin_amdgcn_global_load_lds((const unsigned*)((const char*)(gbase) + (voff)[_i]), (LAS unsigned*)(lds + (bufoff) + ldsw + _i * 8192), 16, 0, 0); } while (0)
#define PG8_LDA(dst, b, h) do { _Pragma("unroll") for (int m = 0; m < 4; ++m) _Pragma("unroll") for (int k = 0; k < 2; ++k) dst[m][k] = *(const LAS bf16x8*)(lds + PG8_SA(b, h) + aoff + m * 2048 + k * 1024); } while (0)
#define PG8_LDB(dst, b, h) do { _Pragma("unroll") for (int n = 0; n < 2; ++n) _Pragma("unroll") for (int k = 0; k < 2; ++k) dst[n][k] = *(const LAS bf16x8*)(lds + PG8_SB(b, h) + boff + n * 2048 + k * 1024); } while (0)
#define PG8_MMA(ai, bj, At, Bt) do { __builtin_amdgcn_s_setprio(1); _Pragma("unroll") for (int m = 0; m < 4; ++m) _Pragma("unroll") for (int n = 0; n < 2; ++n) _Pragma("unroll") for (int k = 0; k < 2; ++k) \
        acc[ai][bj][m][n] = __builtin_amdgcn_mfma_f32_16x16x32_bf16(Bt[n][k], At[m][k], acc[ai][bj][m][n], 0, 0, 0); __builtin_amdgcn_s_setprio(0); } while (0)
#define PG8_WAIT_V(n) asm volatile("s_waitcnt vmcnt(" #n ")" ::: "memory")
#define PG8_WAIT_L(n) asm volatile("s_waitcnt lgkmcnt(" #n ")" ::: "memory")
#define PG8_BAR __builtin_amdgcn_s_barrier()
#define PG8_SCHED __builtin_amdgcn_sched_barrier(0)
    Unit cur, nxt; int ui = 0;
    if (!S.next(0, cur)) return;
    f32x4 acc[2][2][4][2];
#pragma unroll
    for (int a = 0; a < 2; ++a)
#pragma unroll
        for (int b = 0; b < 2; ++b)
#pragma unroll
            for (int m = 0; m < 4; ++m)
#pragma unroll
                for (int n = 0; n < 2; ++n) acc[a][b][m][n] = (f32x4){0.f, 0.f, 0.f, 0.f};
    bf16x8 At[4][2], B0[2][2], B1[2][2];
    const char* cA = (const char*)g.A + (size_t)cur.pm * tstepA; const char* cB = (const char*)g.Bt + (size_t)cur.pn * tstepB;
    PG8_STAGE(PG8_SB(0, 0), cB, voffB); PG8_STAGE(PG8_SB(0, 1), cB + hstepB, voffB); PG8_STAGE(PG8_SA(0, 0), cA, voffA); PG8_STAGE(PG8_SA(0, 1), cA + hstepA, voffA);
    if (wr == 1) PG8_BAR;
    PG8_WAIT_V(2); PG8_BAR;
    PG8_STAGE(PG8_SB(1, 0), cB + kstep, voffB); PG8_STAGE(PG8_SA(1, 0), cA + kstep, voffA); PG8_STAGE(PG8_SB(1, 1), cB + hstepB + kstep, voffB);
    PG8_WAIT_V(6); PG8_BAR;
    for (;;) {
        const bool has_next = S.next(ui + 1, nxt);
        const char* nA = has_next ? (const char*)g.A + (size_t)nxt.pm * tstepA : cA; const char* nB = has_next ? (const char*)g.Bt + (size_t)nxt.pn * tstepB : cB;
        for (int t = 0; t < nt; t += 2) {
            const bool last = (t == nt - 2);
            const char* a1 = cA + (size_t)(t + 1) * kstep;
            const char* a2 = last ? nA : cA + (size_t)(t + 2) * kstep; const char* b2 = last ? nB : cB + (size_t)(t + 2) * kstep;
            const char* a3 = a2 + kstep; const char* b3 = b2 + kstep;
            PG8_LDB(B0, 0, 0); PG8_LDB(B1, 0, 1); PG8_SCHED; PG8_LDA(At, 0, 0); PG8_STAGE(PG8_SA(1, 1), a1 + hstepA, voffA);
            PG8_WAIT_V(8); PG8_WAIT_L(0); PG8_BAR; PG8_MMA(0, 0, At, B0); PG8_MMA(0, 1, At, B1); PG8_BAR; PG8_SCHED;
            PG8_LDA(At, 0, 1); PG8_STAGE(PG8_SB(0, 0), b2, voffB); PG8_STAGE(PG8_SB(0, 1), b2 + hstepB, voffB); PG8_STAGE(PG8_SA(0, 0), a2, voffA);
            PG8_WAIT_V(8); PG8_WAIT_L(0); PG8_BAR; PG8_MMA(1, 0, At, B0); PG8_MMA(1, 1, At, B1); PG8_BAR; PG8_SCHED;
            PG8_LDB(B0, 1, 0); PG8_LDB(B1, 1, 1); PG8_SCHED; PG8_LDA(At, 1, 0); PG8_STAGE(PG8_SA(0, 1), a2 + hstepA, voffA);
            PG8_WAIT_V(8); PG8_WAIT_L(0); PG8_BAR; PG8_MMA(0, 0, At, B0); PG8_MMA(0, 1, At, B1); PG8_BAR; PG8_SCHED;
            PG8_LDA(At, 1, 1); PG8_STAGE(PG8_SB(1, 0), b3, voffB); PG8_STAGE(PG8_SB(1, 1), b3 + hstepB, voffB); PG8_STAGE(PG8_SA(1, 0), a3, voffA);
            PG8_WAIT_V(8); PG8_WAIT_L(0); PG8_BAR; PG8_MMA(1, 0, At, B0); PG8_MMA(1, 1, At, B1); PG8_BAR; PG8_SCHED;
        }
        if constexpr (ALIGN_EPI) { if (wr == 0) PG8_BAR; }
        E(acc, cur, wr, wc, fr, fq);
        if (!has_next) break;
#pragma unroll
        for (int a = 0; a < 2; ++a)
#pragma unroll
            for (int b = 0; b < 2; ++b)
#pragma unroll
                for (int m = 0; m < 4; ++m)
#pragma unroll
                    for (int n = 0; n < 2; ++n) acc[a][b][m][n] = (f32x4){0.f, 0.f, 0.f, 0.f};
        cur = nxt; cA = nA; cB = nB; ++ui;
        if constexpr (ALIGN_EPI) { if (wr == 1) PG8_BAR; }
    }
    PG8_WAIT_V(0);
    if constexpr (!ALIGN_EPI) { if (wr == 0) PG8_BAR; }
    PG8_BAR;
#undef PG8_SA
#undef PG8_SB
#undef PG8_STAGE
#undef PG8_LDA
#undef PG8_LDB
#undef PG8_MMA
#undef PG8_WAIT_V
#undef PG8_WAIT_L
#undef PG8_BAR
#undef PG8_SCHED
}
}

DI void cvt_item(const float* W, int K, int N, bf16_t* WT, const float* kgain, int half, LAS float* scr, int item, int lane) {
    const int nblk = N / 32, kb = item / nblk, nb = item % nblk, k0 = 64 * kb, n0 = 32 * nb;
    const int kq = lane >> 3, nq = lane & 7;
    f32x4 v[8];
#pragma unroll
    for (int i = 0; i < 8; ++i) v[i] = *(const f32x4*)(W + (size_t)(k0 + 8 * i + kq) * N + n0 + 4 * nq);
#pragma unroll
    for (int i = 0; i < 8; ++i) { const int kk = 8 * i + kq; const float gk = kgain ? kgain[k0 + kk] : 1.0f;
        LAS float* d = scr + kk * 33 + 4 * nq; d[0] = v[i][0] * gk; d[1] = v[i][1] * gk; d[2] = v[i][2] * gk; d[3] = v[i][3] * gk; }
    asm volatile("s_waitcnt lgkmcnt(0)" ::: "memory");
    const int c = lane & 7;
#pragma unroll
    for (int j = 0; j < 4; ++j) { const int n = (lane >> 3) + 8 * j; const LAS float* s = scr + (8 * c) * 33 + n;
        u32x4 o; o.x = pk2(s[0 * 33], s[1 * 33]); o.y = pk2(s[2 * 33], s[3 * 33]); o.z = pk2(s[4 * 33], s[5 * 33]); o.w = pk2(s[6 * 33], s[7 * 33]);
        const int ns = n0 + n; const int nd = half ? (ns < half ? 2 * ns : 2 * (ns - half) + 1) : ns;
        *(u32x4*)(WT + (size_t)nd * K + k0 + 8 * c) = o; }
    asm volatile("s_waitcnt lgkmcnt(0)" ::: "memory");
}

DI void phase0(PPtr p, ldsp lds, int tid, int wave, int lane) {
    LAS float* sc = (LAS float*)lds;
    LAS float* red = (LAS float*)(lds + 16384);
    LAS float* red2 = (LAS float*)(lds + 16384 + 32768);
    for (int i = tid; i < 4096; i += 512) { const float v = p->c[i]; sc[i] = v / (1.0f + __expf(-v)); }
    __syncthreads();
    float* mods = (float*)(p->ws + WS_MODS);
    const int cgp = tid & 7, ks = tid >> 3;
    for (int item = blockIdx.x; item < 1152; item += gridDim.x) {
        const int ge0 = item * 32, l = ge0 / 9216, e0 = ge0 % 9216;
        const float* W = p->ada_w + (size_t)l * 1024 * 9216 + e0 + 4 * cgp;
        f32x4 acc[4];
#pragma unroll
        for (int b = 0; b < 4; ++b) acc[b] = (f32x4){0.f, 0.f, 0.f, 0.f};
        f32x4 wv[16];
#pragma unroll
        for (int kk = 0; kk < 16; ++kk) wv[kk] = *(const f32x4*)(W + (size_t)(ks * 16 + kk) * 9216);
#pragma unroll
        for (int kk = 0; kk < 16; ++kk) { const int k = ks * 16 + kk;
#pragma unroll
            for (int b = 0; b < 4; ++b) acc[b] += wv[kk] * sc[b * 1024 + k]; }
#pragma unroll
        for (int b = 0; b < 4; ++b) *(LAS f32x4*)(red + ks * 128 + b * 32 + 4 * cgp) = acc[b];
        __syncthreads();
        { const int oc = tid & 127, part = tid >> 7; float s = 0.f;
#pragma unroll
          for (int j = 0; j < 16; ++j) s += red[(part * 16 + j) * 128 + oc];
          red2[part * 128 + oc] = s; }
        __syncthreads();
        if (tid < 128) { const float s = (red2[tid] + red2[128 + tid]) + (red2[256 + tid] + red2[384 + tid]);
            const int b = tid >> 5, col = tid & 31;
            mods[(size_t)(l * 4 + b) * 9216 + e0 + col] = s + p->ada_b[l * 9216 + e0 + col]; }
    }
    LAS float* scr = (LAS float*)(lds + 65536 + wave * 8448);
    const int gw = blockIdx.x * 8 + wave, ngw = gridDim.x * 8;
    constexpr int I_GU = 16 * 176, I_DN = 44 * 32, I_A = 16 * 21, I_QB = 6 * 48, I_KVB = 4 * 64, I_O = 16 * 32, I_IN = 16 * 161, I_OUT = 32 * 32;
    constexpr int NITEMS = 8 * I_GU + 8 * I_DN + 2 * (I_A + I_QB + I_KVB + I_O + I_IN + I_OUT);
    for (int it = gw; it < NITEMS; it += ngw) {
        int r = it; const float* src; bf16_t* dst; const float* kg = nullptr; int K, N, half = 0, li, m;
        if (r < 8 * I_GU) { m = r / I_GU; li = r % I_GU; K = 1024; N = 5632; half = 2816; src = p->ffn_w_gu + (size_t)m * 1024 * 5632; dst = (bf16_t*)(p->ws + WS_WGU + m * SZ_WGU); }
        else if ((r -= 8 * I_GU) < 8 * I_DN) { m = r / I_DN; li = r % I_DN; K = 2816; N = 1024; src = p->ffn_w_down + (size_t)m * 2816 * 1024; dst = (bf16_t*)(p->ws + WS_WDN + m * SZ_WDN); }
        else if ((r -= 8 * I_DN) < 2 * I_A) { m = r / I_A; li = r % I_A; K = 1024; N = ADIM; src = p->mla_w_a + (size_t)m * 1024 * ADIM; dst = (bf16_t*)(p->ws + WS_WA + m * SZ_WA); }
        else if ((r -= 2 * I_A) < 2 * I_QB) { m = r / I_QB; li = r % I_QB; K = 384; N = 1536; src = p->mla_w_qb + (size_t)m * 384 * 1536; dst = (bf16_t*)(p->ws + WS_WQB + m * SZ_WQB); kg = p->mla_q_a_gain + m * 384; }
        else if ((r -= 2 * I_QB) < 2 * I_KVB) { m = r / I_KVB; li = r % I_KVB; K = 256; N = 2048; src = p->mla_w_kvb + (size_t)m * 256 * 2048; dst = (bf16_t*)(p->ws + WS_WKVB + m * SZ_WKVB); kg = p->mla_kv_a_gain + m * 256; }
        else if ((r -= 2 * I_KVB) < 2 * I_O) { m = r / I_O; li = r % I_O; K = 1024; N = 1024; src = p->mla_w_o + (size_t)m * 1024 * 1024; dst = (bf16_t*)(p->ws + WS_WO + m * SZ_WO); }
        else if ((r -= 2 * I_O) < 2 * I_IN) { m = r / I_IN; li = r % I_IN; K = 1024; N = INP; src = p->ssd_w_in + (size_t)m * 1024 * INP; dst = (bf16_t*)(p->ws + WS_WIN + m * SZ_WIN); }
        else { r -= 2 * I_IN; m = r / I_OUT; li = r % I_OUT; K = 2048; N = 1024; src = p->ssd_w_out + (size_t)m * 2048 * 1024; dst = (bf16_t*)(p->ws + WS_WOUT + m * SZ_WOUT); kg = p->ssd_norm_gain + m * 2048; }
        cvt_item(src, K, N, dst, kg, half, scr, li, lane);
    }
    constexpr int PA = (ADIMP - ADIM) * 1024 * 2 / 16, PI = (INPP - INP) * 1024 * 2 / 16;
    const u32x4 z4 = {0u, 0u, 0u, 0u};
    for (int i = blockIdx.x * 512 + tid; i < 2 * (PA + PI); i += gridDim.x * 512) {
        int r = i; unsigned char* d;
        if (r < 2 * PA) { const int m = r / PA; d = p->ws + WS_WA + m * SZ_WA + (size_t)ADIM * 1024 * 2 + (size_t)(r % PA) * 16; }
        else { r -= 2 * PA; const int m = r / PI; d = p->ws + WS_WIN + m * SZ_WIN + (size_t)INP * 1024 * 2 + (size_t)(r % PI) * 16; }
        *(u32x4*)d = z4;
    }
}

DI void norm_phase(const float* xin, const float* gain, const float* mods_ls, bf16_t* h, int wave, int lane) {
    const int vb = (gridDim.x == 256) ? ((blockIdx.x & 7) * 32 + (blockIdx.x >> 3)) : (int)blockIdx.x;
    const int gw = vb * 8 + wave, ngw = gridDim.x * 8;
    for (int blk = gw; blk < T / 8; blk += ngw) {
        const int m0 = blk * 8, b = m0 >> 12;
        const float* shift = mods_ls + (size_t)b * 9216; const float* scale = shift + 1024;
        f32x4 gsc[4], sh[4];
#pragma unroll
        for (int j = 0; j < 4; ++j) { const int c = 4 * lane + 256 * j; gsc[j] = *(const f32x4*)(gain + c) * (*(const f32x4*)(scale + c) + 1.0f); sh[j] = *(const f32x4*)(shift + c); }
#pragma unroll 2
        for (int r = 0; r < 8; ++r) {
            const float* xr = xin + (size_t)(m0 + r) * DM + 4 * lane;
            f32x4 v[4]; float ss = 0.f;
#pragma unroll
            for (int j = 0; j < 4; ++j) { v[j] = *(const f32x4*)(xr + 256 * j); ss += (v[j].x * v[j].x + v[j].y * v[j].y) + (v[j].z * v[j].z + v[j].w * v[j].w); }
            const float rstd = rsqrtf(wave_sum(ss) * (1.0f / DM) + EPS);
            bf16_t* hr = h + (size_t)(m0 + r) * DM + 4 * lane;
#pragma unroll
            for (int j = 0; j < 4; ++j) { const f32x4 o = v[j] * rstd * gsc[j] + sh[j]; u32x2 w; w.x = pk2(o.x, o.y); w.y = pk2(o.z, o.w); *(u32x2*)(hr + 256 * j) = w; }
        }
    }
}

DI void mla_finalize(PPtr p, int j, ldsp lds, int tid, int wave, int lane) {
    const bf16_t* aout = (const bf16_t*)(p->ws + WS_AOUT); const bf16_t* qraw = (const bf16_t*)(p->ws + WS_QRAW); const bf16_t* kvraw = (const bf16_t*)(p->ws + WS_KVRAW);
    bf16_t* Qb = (bf16_t*)(p->ws + WS_QB); bf16_t* Kb = (bf16_t*)(p->ws + WS_KB); bf16_t* Vt = (bf16_t*)(p->ws + WS_VT);
    const float* qg = p->mla_q_gain + j * QKH; const float* kg = p->mla_k_gain + j * QKH;
    constexpr int VTP = 40;
    const int head = lane >> 2, sub = lane & 3;
    for (int item = blockIdx.x; item < T / 32; item += gridDim.x) {
        const int t0 = item * 32, b = t0 >> 12, s0 = t0 & 4095;
        for (int rr = 0; rr < 4; ++rr) {
            const int tok = wave * 4 + rr, t = t0 + tok;
            float ssq = 0.f, sskv = 0.f;
            if (lane < 48) { const u32x4 w = *(const u32x4*)(aout + (size_t)t * ADIMP + 8 * lane);
#pragma unroll
                for (int i = 0; i < 4; ++i) { const float a = bflo(w[i]), c = bfhi(w[i]); ssq += a * a + c * c; } }
            if (lane < 32) { const u32x4 w = *(const u32x4*)(aout + (size_t)t * ADIMP + QL + 8 * lane);
#pragma unroll
                for (int i = 0; i < 4; ++i) { const float a = bflo(w[i]), c = bfhi(w[i]); sskv += a * a + c * c; } }
            const float rq = rsqrtf(wave_sum(ssq) * (1.0f / QL) + EPS), rkv = rsqrtf(wave_sum(sskv) * (1.0f / KVL) + EPS);
            float cs, sn;
            { const int fi = lane & 15; const float inv = exp2f(-(float)fi * (13.287712379549449f / 16.0f));
              const float ang = (float)p->pos[t] * inv; double rev = (double)ang * 0.15915494309189535; rev -= floor(rev); const float rv = (float)rev;
              cs = __builtin_amdgcn_cosf(rv); sn = __builtin_amdgcn_sinf(rv); }
            float cj[8], sj[8];
#pragma unroll
            for (int i = 0; i < 8; ++i) { cj[i] = __shfl(cs, 8 * (sub & 1) + i); sj[i] = __shfl(sn, 8 * (sub & 1) + i); }
#pragma unroll
            for (int which = 0; which < 2; ++which) {
                float v[24];
                if (which == 0) {
                    const bf16_t* src = qraw + (size_t)t * 1536 + head * QKH;
#pragma unroll
                    for (int g = 0; g < 3; ++g) { const u32x4 w = *(const u32x4*)(src + 8 * (sub + 4 * g));
#pragma unroll
                        for (int i = 0; i < 4; ++i) { v[8 * g + 2 * i] = bflo(w[i]) * rq; v[8 * g + 2 * i + 1] = bfhi(w[i]) * rq; } }
                } else {
                    const bf16_t* src = kvraw + (size_t)t * 2048 + head * 128;
#pragma unroll
                    for (int g = 0; g < 2; ++g) { const u32x4 w = *(const u32x4*)(src + 8 * (sub + 4 * g));
#pragma unroll
                        for (int i = 0; i < 4; ++i) { v[8 * g + 2 * i] = bflo(w[i]) * rkv; v[8 * g + 2 * i + 1] = bfhi(w[i]) * rkv; } }
                    const u32x4 w = *(const u32x4*)(aout + (size_t)t * ADIMP + QL + KVL + 8 * sub);
#pragma unroll
                    for (int i = 0; i < 4; ++i) { v[16 + 2 * i] = bflo(w[i]); v[16 + 2 * i + 1] = bfhi(w[i]); }
                }
                float ss = 0.f;
#pragma unroll
                for (int i = 0; i < 24; ++i) ss += v[i] * v[i];
                ss += __shfl_xor(ss, 1); ss += __shfl_xor(ss, 2);
                const float rs = rsqrtf(ss * (1.0f / QKH) + EPS);
                const float* gn = which == 0 ? qg : kg;
#pragma unroll
                for (int g = 0; g < 3; ++g) { const f32x4 g0 = *(const f32x4*)(gn + 8 * (sub + 4 * g)), g1 = *(const f32x4*)(gn + 8 * (sub + 4 * g) + 4);
#pragma unroll
                    for (int i = 0; i < 4; ++i) { v[8 * g + i] *= rs * g0[i]; v[8 * g + 4 + i] *= rs * g1[i]; } }
#pragma unroll
                for (int i = 0; i < 8; ++i) { const float mine = v[16 + i], other = __shfl_xor(mine, 2);
                    v[16 + i] = (sub < 2) ? (mine * cj[i] - other * sj[i]) : (other * sj[i] + mine * cj[i]); }
                const float osc = which == 0 ? QSCALE : 1.0f;
                bf16_t* dst = (which == 0 ? Qb : Kb) + ((size_t)t * HEADS + head) * QKH;
#pragma unroll
                for (int g = 0; g < 3; ++g) { u32x4 w;
#pragma unroll
                    for (int i = 0; i < 4; ++i) w[i] = pk2(v[8 * g + 2 * i] * osc, v[8 * g + 2 * i + 1] * osc);
                    *(u32x4*)(dst + 8 * (sub + 4 * g)) = w; }
            }
            { const bf16_t* src = kvraw + (size_t)t * 2048 + head * 128 + 64 + 16 * sub;
#pragma unroll
              for (int g = 0; g < 2; ++g) { const u32x4 w = *(const u32x4*)(src + 8 * g);
#pragma unroll
                  for (int i = 0; i < 4; ++i) { const int d = head * 64 + 16 * sub + 8 * g + 2 * i;
                      *(LAS bf16_t*)(lds + ((d) * VTP + tok) * 2) = f2bf(bflo(w[i]) * rkv);
                      *(LAS bf16_t*)(lds + ((d + 1) * VTP + tok) * 2) = f2bf(bfhi(w[i]) * rkv); } } }
        }
        __syncthreads();
#pragma unroll
        for (int k = 0; k < 8; ++k) { const int id = tid + 512 * k, row = id >> 2, ch = id & 3;
            const u32x4 w = *(const LAS u32x4*)(lds + (row * VTP + ch * 8) * 2);
            *(u32x4*)(Vt + ((size_t)b * 1024 + row) * SEQ + s0 + ch * 8) = w; }
        __syncthreads();
    }
}

DI void attn_phase(PPtr p, int j, ldsp lds, int tid, int wave, int lane) {
    const bf16_t* Qb = (const bf16_t*)(p->ws + WS_QB); const bf16_t* Kb = (const bf16_t*)(p->ws + WS_KB); const bf16_t* Vt = (const bf16_t*)(p->ws + WS_VT);
    bf16_t* O = (bf16_t*)(p->ws + WS_O);
    constexpr int KP = 104, VP = 68, KBYTES = 64 * KP * 2, VBYTES = 64 * VP * 2, BUF = KBYTES + VBYTES;
    const int r = lane & 31, hi = lane >> 5;
    const int k1row = tid / 12, k1ch = tid % 12, k2row = (tid + 512) / 12, k2ch = (tid + 512) % 12, vrow = tid >> 3, vch = tid & 7;
    float mfix;
    { float gq = fabsf(p->mla_q_gain[j * QKH + lane]), gk = fabsf(p->mla_k_gain[j * QKH + lane]);
      if (lane < 32) { gq = fmaxf(gq, fabsf(p->mla_q_gain[j * QKH + 64 + lane])); gk = fmaxf(gk, fabsf(p->mla_k_gain[j * QKH + 64 + lane])); }
#pragma unroll
      for (int o = 1; o < 64; o <<= 1) { gq = fmaxf(gq, __shfl_xor(gq, o)); gk = fmaxf(gk, __shfl_xor(gk, o)); }
      mfix = QSCALE * 96.0f * gq * gk; }
    for (int item = blockIdx.x; item < 512; item += gridDim.x) {
        const int bh = item >> 3, jj = item & 7, b = bh >> 4, hd = bh & 15;
        const bf16_t* kbase = Kb + ((size_t)b * SEQ * HEADS + hd) * QKH;
        const bf16_t* vbase = Vt + ((size_t)(b * HEADS + hd) * 64) * SEQ;
        for (int half = 0; half < 2; ++half) {
            const int qb = half ? 15 - jj : jj, q0 = qb * 256, nt = 4 * qb + 4;
            const int qrow = q0 + 32 * wave + r;
            bf16x8 qf[6];
            { const bf16_t* qp = Qb + ((size_t)(b * SEQ + qrow) * HEADS + hd) * QKH + 8 * hi;
#pragma unroll
              for (int ks = 0; ks < 6; ++ks) qf[ks] = *(const bf16x8*)(qp + 16 * ks); }
            f32x16 o0, o1;
#pragma unroll
            for (int i = 0; i < 16; ++i) { o0[i] = 0.f; o1[i] = 0.f; }
            float lrun = 0.f;
            u32x4 kr1, kr2 = {0u, 0u, 0u, 0u}, vr;
#define ATT_LOAD(kt) do { kr1 = *(const u32x4*)(kbase + (size_t)(64 * (kt) + k1row) * (HEADS * QKH) + k1ch * 8); \
                if (tid < 256) kr2 = *(const u32x4*)(kbase + (size_t)(64 * (kt) + k2row) * (HEADS * QKH) + k2ch * 8); \
                vr = *(const u32x4*)(vbase + (size_t)vrow * SEQ + 64 * (kt) + vch * 8); } while (0)
#define ATT_STORE(bf) do { *(LAS u32x4*)(lds + (bf) * BUF + (k1row * KP + k1ch * 8) * 2) = kr1; \
                if (tid < 256) *(LAS u32x4*)(lds + (bf) * BUF + (k2row * KP + k2ch * 8) * 2) = kr2; \
                *(LAS u32x2*)(lds + (bf) * BUF + KBYTES + (vrow * VP + vch * 8) * 2) = (u32x2){vr[0], vr[1]}; \
                *(LAS u32x2*)(lds + (bf) * BUF + KBYTES + (vrow * VP + vch * 8) * 2 + 8) = (u32x2){vr[2], vr[3]}; } while (0)
            ATT_LOAD(0); ATT_STORE(0);
            __syncthreads();
            for (int kt = 0; kt < nt; ++kt) {
                const int buf = kt & 1;
                if (kt + 1 < nt) ATT_LOAD(kt + 1);
                const int k0 = 64 * kt;
                if (k0 <= q0 + 32 * wave + 31) {
                    f32x16 s0, s1;
#pragma unroll
                    for (int i = 0; i < 16; ++i) { s0[i] = -mfix; s1[i] = -mfix; }
                    const ldsp kb0 = lds + buf * BUF + (r * KP + 8 * hi) * 2;
                    bf16x8 ka[6], kc[6];
#pragma unroll
                    for (int ks = 0; ks < 6; ++ks) { ka[ks] = *(const LAS bf16x8*)(kb0 + ks * 32); kc[ks] = *(const LAS bf16x8*)(kb0 + 32 * KP * 2 + ks * 32); }
                    __builtin_amdgcn_sched_barrier(0);
#pragma unroll
                    for (int ks = 0; ks < 6; ++ks) s0 = MFMA32(ka[ks], qf[ks], s0);
#pragma unroll
                    for (int ks = 0; ks < 6; ++ks) s1 = MFMA32(kc[ks], qf[ks], s1);
                    const ldsp vb0 = lds + buf * BUF + KBYTES + (r * VP + 4 * hi) * 2;
                    s16x4 vlo0[4], vhi0[4], vlo1[4], vhi1[4];
#pragma unroll
                    for (int q = 0; q < 4; ++q) { const ldsp va = vb0 + (16 * q) * 2;
                        vlo0[q] = *(const LAS s16x4*)(va); vhi0[q] = *(const LAS s16x4*)(va + 16);
                        vlo1[q] = *(const LAS s16x4*)(va + 32 * VP * 2); vhi1[q] = *(const LAS s16x4*)(va + 32 * VP * 2 + 16); }
                    const bool diag = (k0 + 63 > q0 + 32 * wave);
                    float psum = 0.f;
                    if (diag) {
#pragma unroll
                        for (int i = 0; i < 16; ++i) { const int key = k0 + crow(i, hi); if (key > qrow) s0[i] = -INFINITY; }
                    }
#pragma unroll
                    for (int i = 0; i < 16; ++i) { s0[i] = __builtin_amdgcn_exp2f(s0[i]); psum += s0[i]; }
#pragma unroll
                    for (int q = 0; q < 2; ++q) { const bf16x8 pf = pack8(s0, q);
                        const bf16x8 vf0 = __builtin_shufflevector(vlo0[q], vhi0[q], 0, 1, 2, 3, 4, 5, 6, 7), vf1 = __builtin_shufflevector(vlo1[q], vhi1[q], 0, 1, 2, 3, 4, 5, 6, 7);
                        o0 = MFMA32(vf0, pf, o0); o1 = MFMA32(vf1, pf, o1); }
                    if (diag) {
#pragma unroll
                        for (int i = 0; i < 16; ++i) { const int key = k0 + 32 + crow(i, hi); if (key > qrow) s1[i] = -INFINITY; }
                    }
#pragma unroll
                    for (int i = 0; i < 16; ++i) { s1[i] = __builtin_amdgcn_exp2f(s1[i]); psum += s1[i]; }
                    lrun += psum;
#pragma unroll
                    for (int q = 2; q < 4; ++q) { const bf16x8 pf = pack8(s1, q & 1);
                        const bf16x8 vf0 = __builtin_shufflevector(vlo0[q], vhi0[q], 0, 1, 2, 3, 4, 5, 6, 7), vf1 = __builtin_shufflevector(vlo1[q], vhi1[q], 0, 1, 2, 3, 4, 5, 6, 7);
                        o0 = MFMA32(vf0, pf, o0); o1 = MFMA32(vf1, pf, o1); }
                }
                if (kt + 1 < nt) ATT_STORE(buf ^ 1);
                __syncthreads();
            }
#undef ATT_LOAD
#undef ATT_STORE
            const float inv = 1.0f / (lrun + __shfl_xor(lrun, 32));
            bf16_t* op = O + (size_t)(b * SEQ + qrow) * DM + hd * 64 + 4 * hi;
#pragma unroll
            for (int g = 0; g < 4; ++g) {
                u32x2 w0, w1; w0.x = pk2(o0[4 * g] * inv, o0[4 * g + 1] * inv); w0.y = pk2(o0[4 * g + 2] * inv, o0[4 * g + 3] * inv);
                w1.x = pk2(o1[4 * g] * inv, o1[4 * g + 1] * inv); w1.y = pk2(o1[4 * g + 2] * inv, o1[4 * g + 3] * inv);
                *(u32x2*)(op + 8 * g) = w0; *(u32x2*)(op + 32 + 8 * g) = w1; }
        }
    }
}

DI void conv_phase(PPtr p, int j, ldsp lds, int tid) {
    const bf16_t* zx = (const bf16_t*)(p->ws + WS_ZX);
    bf16_t* xT = (bf16_t*)(p->ws + WS_XT); bf16_t* Bc = (bf16_t*)(p->ws + WS_BC); bf16_t* Cc = (bf16_t*)(p->ws + WS_CC); bf16_t* BT = (bf16_t*)(p->ws + WS_BT);
    const float* cw = p->ssd_conv_w + (size_t)j * 4 * CONVD; const float* cbias = p->ssd_conv_b + (size_t)j * CONVD;
    constexpr int TPB = 140;
    {
        const int lane = tid & 63, wave = tid >> 6, r = lane & 31, hi = lane >> 5, kq = wave & 3;
        const bf16_t* hb = (const bf16_t*)(p->ws + WS_H); const bf16_t* wdt = (const bf16_t*)(p->ws + WS_WIN + (size_t)j * SZ_WIN) + (size_t)ZXW * DM;
        float* dtraw = (float*)(p->ws + WS_DTRAW);
        for (int base = blockIdx.x * 2; base < T / 32; base += gridDim.x * 2) {
            const int rt = base + (wave >> 2);
            const bf16_t* ap = hb + (size_t)(rt * 32 + r) * DM + kq * 256 + 8 * hi; const bf16_t* bp = wdt + (size_t)r * DM + kq * 256 + 8 * hi;
            f32x16 d0, d1;
#pragma unroll
            for (int i = 0; i < 16; ++i) { d0[i] = 0.f; d1[i] = 0.f; }
            bf16x8 fa[16], fb[16];
#pragma unroll
            for (int ks = 0; ks < 16; ++ks) { fa[ks] = *(const bf16x8*)(ap + ks * 16); fb[ks] = *(const bf16x8*)(bp + ks * 16); }
#pragma unroll
            for (int ks = 0; ks < 16; ks += 2) { d0 = MFMA32(fa[ks], fb[ks], d0); d1 = MFMA32(fa[ks + 1], fb[ks + 1], d1); }
#pragma unroll
            for (int i = 0; i < 16; ++i) *(LAS float*)(lds + ((wave * 16 + i) * 64 + lane) * 4) = d0[i] + d1[i];
            __syncthreads();
            if (kq == 0) {
                float* op = dtraw + (size_t)(rt * 32) * 32 + r;
#pragma unroll
                for (int i = 0; i < 16; ++i) { float v = 0.f;
#pragma unroll
                    for (int q = 0; q < 4; ++q) v += *(const LAS float*)(lds + (((wave + q) * 16 + i) * 64 + lane) * 4);
                    op[(size_t)crow(i, hi) * 32] = v; }
            }
            __syncthreads();
        }
    }
    const int tok = tid >> 3, cgp = tid & 7;
    for (int item = blockIdx.x; item < 256 * 12; item += gridDim.x) {
        const int tt = item / 12, cb = item % 12;
        const int t0 = tt * 64, b = t0 >> 12, s0 = t0 & 4095;
        const int t = t0 + tok, s = s0 + tok;
        u32x4 u[4][4];
#pragma unroll
        for (int k = 0; k < 4; ++k)
#pragma unroll
            for (int w = 0; w < 4; ++w) {
                const int ch0 = cb * 256 + (cgp + 8 * k) * 8;
                if (s - 3 + w >= 0) u[k][w] = *(const u32x4*)(zx + (size_t)(t - 3 + w) * ZXW + DIN + ch0);
                else u[k][w] = (u32x4){0u, 0u, 0u, 0u};
            }
#pragma unroll
        for (int k = 0; k < 4; ++k) {
            const int cl = (cgp + 8 * k) * 8, ch0 = cb * 256 + cl;
            float acc[8];
            { const f32x4 b0 = *(const f32x4*)(cbias + ch0), b1 = *(const f32x4*)(cbias + ch0 + 4);
#pragma unroll
              for (int i = 0; i < 4; ++i) { acc[i] = b0[i]; acc[4 + i] = b1[i]; } }
#pragma unroll
            for (int w = 0; w < 4; ++w) {
                const f32x4 w0 = *(const f32x4*)(cw + w * CONVD + ch0), w1 = *(const f32x4*)(cw + w * CONVD + ch0 + 4);
                const u32x4 uu = u[k][w];
                acc[0] += bflo(uu[0]) * w0[0]; acc[1] += bfhi(uu[0]) * w0[1]; acc[2] += bflo(uu[1]) * w0[2]; acc[3] += bfhi(uu[1]) * w0[3];
                acc[4] += bflo(uu[2]) * w1[0]; acc[5] += bfhi(uu[2]) * w1[1]; acc[6] += bflo(uu[3]) * w1[2]; acc[7] += bfhi(uu[3]) * w1[3];
            }
#pragma unroll
            for (int i = 0; i < 8; ++i) acc[i] = silu_f(acc[i]);
            if (cb >= 8) { u32x4 w; w.x = pk2(acc[0], acc[1]); w.y = pk2(acc[2], acc[3]); w.z = pk2(acc[4], acc[5]); w.w = pk2(acc[6], acc[7]);
                bf16_t* dst = (cb < 10) ? Bc + (size_t)t * 512 + (cb - 8) * 256 + cl : Cc + (size_t)t * 512 + (cb - 10) * 256 + cl;
                *(u32x4*)dst = w; }
            if (cb < 10) {
#pragma unroll
                for (int i = 0; i < 8; ++i) *(LAS bf16_t*)(lds + (cl + i) * TPB + tok * 2) = f2bf(acc[i]);
            }
        }
        if (cb < 10) {
            __syncthreads();
#pragma unroll
            for (int k = 0; k < 4; ++k) { const int id = tid + 512 * k, row = id >> 3, ch = id & 7;
                const ldsp src = lds + row * TPB + ch * 16;
                u32x4 w; w.x = *(const LAS unsigned*)(src); w.y = *(const LAS unsigned*)(src + 4); w.z = *(const LAS unsigned*)(src + 8); w.w = *(const LAS unsigned*)(src + 12);
                bf16_t* dst = (cb < 8) ? xT + ((size_t)b * 2048 + cb * 256 + row) * SEQ + s0 + ch * 8 : BT + ((size_t)b * 512 + (cb - 8) * 256 + row) * SEQ + s0 + ch * 8;
                *(u32x4*)dst = w; }
            __syncthreads();
        }
    }
}

DI void scan_phase(PPtr p, int j, ldsp lds, int tid, int wave, int lane) {
    const bf16_t* xT = (const bf16_t*)(p->ws + WS_XT); const bf16_t* Bc = (const bf16_t*)(p->ws + WS_BC); const bf16_t* Cc = (const bf16_t*)(p->ws + WS_CC);
    const bf16_t* BT = (const bf16_t*)(p->ws + WS_BT); const float* dtraw = (const float*)(p->ws + WS_DTRAW); bf16_t* Y = (bf16_t*)(p->ws + WS_Y);
    constexpr int PT = 136, PB = PT * 2;
    constexpr int O_C = 0, O_B = 128 * PB, O_BT = 2 * 128 * PB, O_X = 3 * 128 * PB, O_XW = O_X + 32 * PB, O_S = O_XW + 32 * PB, O_DT = O_S + 32 * PB, O_AC = O_DT + 8 * 512;
    LAS float* s_dt = (LAS float*)(lds + O_DT + wave * 512); LAS float* s_ac = (LAS float*)(lds + O_AC + wave * 512);
    const int r = lane & 31, hi = lane >> 5;
    for (int unit0 = blockIdx.x; unit0 < 256; unit0 += gridDim.x) {
        const int unit = (gridDim.x == 256) ? ((unit0 & 7) * 32 + (unit0 >> 3)) : unit0;
        const int b = unit >> 6, h = (unit >> 1) & 31, ph = unit & 1, g = h >> 3;
        const float A = -__expf(p->ssd_a_log[j * SSDH + h]); const float dtb = p->ssd_dt_bias[j * SSDH + h]; const float Dh = p->ssd_d[j * SSDH + h];
        f32x16 accS;
#pragma unroll
        for (int i = 0; i < 16; ++i) accS[i] = 0.f;
        for (int i = tid; i < 32 * PB / 4; i += 512) *(LAS unsigned*)(lds + O_S + i * 4) = 0u;
        u32x4 rc[4], rb[4], rbt[4], rx; float dr0, dr1;
        const unsigned offRow = (unsigned)((tid >> 4) * 512 + (tid & 15) * 8), offT = (unsigned)((tid >> 4) * SEQ + (tid & 15) * 8);
        const bf16_t* cBase = Cc + (size_t)b * SEQ * 512 + g * 128; const bf16_t* bBase = Bc + (size_t)b * SEQ * 512 + g * 128;
        const bf16_t* btBase = BT + ((size_t)b * 512 + g * 128) * SEQ; const bf16_t* xBase = xT + ((size_t)b * 2048 + h * 64 + ph * 32) * SEQ;
        const float* dBase = dtraw + (size_t)b * SEQ * 32 + h;
#define SCAN_LOAD(c) do { const bf16_t* c_ = cBase + (size_t)(c) * 128 * 512; const bf16_t* b_ = bBase + (size_t)(c) * 128 * 512; const bf16_t* bt_ = btBase + (c) * 128; \
            _Pragma("unroll") for (int k = 0; k < 4; ++k) { \
                rc[k] = *(const u32x4*)(c_ + (offRow + (unsigned)(k * 32 * 512))); \
                rb[k] = *(const u32x4*)(b_ + (offRow + (unsigned)(k * 32 * 512))); \
                rbt[k] = *(const u32x4*)(bt_ + (offT + (unsigned)(k * 32 * SEQ))); } \
            rx = *(const u32x4*)(xBase + (c) * 128 + offT); \
            dr0 = dBase[(unsigned)(((c) * 128 + lane) * 32)]; dr1 = dBase[(unsigned)(((c) * 128 + lane + 64) * 32)]; } while (0)
        SCAN_LOAD(0);
        for (int c = 0; c < 32; ++c) {
            const int t0 = b * SEQ + c * 128;
            {
                const float x0 = dr0 + dtb, x1 = dr1 + dtb;
                const float d0 = x0 > 20.f ? x0 : log1pf(__expf(x0)), d1 = x1 > 20.f ? x1 : log1pf(__expf(x1));
                float v0 = d0 * A * 1.4426950408889634f, v1 = d1 * A * 1.4426950408889634f;
#pragma unroll
                for (int off = 1; off < 64; off <<= 1) { const float n0 = __shfl_up(v0, off), n1 = __shfl_up(v1, off); if (lane >= off) { v0 += n0; v1 += n1; } }
                v1 += __shfl(v0, 63);
                s_dt[lane] = d0; s_dt[lane + 64] = d1; s_ac[lane] = v0; s_ac[lane + 64] = v1;
            }
#pragma unroll
            for (int k = 0; k < 4; ++k) { const int id = tid + 512 * k, row = id >> 4, ch = id & 15; const int off = (row * PT + ch * 8) * 2;
                *(LAS u32x4*)(lds + O_C + off) = rc[k]; *(LAS u32x4*)(lds + O_B + off) = rb[k]; *(LAS u32x4*)(lds + O_BT + off) = rbt[k]; }
            { const int row = tid >> 4, ch = tid & 15; const int off = (row * PT + ch * 8) * 2;
              const float aend = s_ac[127]; u32x4 w, wd;
              const f32x4 da = *(const LAS f32x4*)(s_dt + ch * 8), db = *(const LAS f32x4*)(s_dt + ch * 8 + 4), aa = *(const LAS f32x4*)(s_ac + ch * 8), ab = *(const LAS f32x4*)(s_ac + ch * 8 + 4);
              float xd[8];
              xd[0] = bflo(rx[0]) * da[0]; xd[1] = bfhi(rx[0]) * da[1]; xd[2] = bflo(rx[1]) * da[2]; xd[3] = bfhi(rx[1]) * da[3];
              xd[4] = bflo(rx[2]) * db[0]; xd[5] = bfhi(rx[2]) * db[1]; xd[6] = bflo(rx[3]) * db[2]; xd[7] = bfhi(rx[3]) * db[3];
              wd[0] = pk2(xd[0], xd[1]); wd[1] = pk2(xd[2], xd[3]); wd[2] = pk2(xd[4], xd[5]); wd[3] = pk2(xd[6], xd[7]);
              w[0] = pk2(xd[0] * __builtin_amdgcn_exp2f(aend - aa[0]), xd[1] * __builtin_amdgcn_exp2f(aend - aa[1]));
              w[1] = pk2(xd[2] * __builtin_amdgcn_exp2f(aend - aa[2]), xd[3] * __builtin_amdgcn_exp2f(aend - aa[3]));
              w[2] = pk2(xd[4] * __builtin_amdgcn_exp2f(aend - ab[0]), xd[5] * __builtin_amdgcn_exp2f(aend - ab[1]));
              w[3] = pk2(xd[6] * __builtin_amdgcn_exp2f(aend - ab[2]), xd[7] * __builtin_amdgcn_exp2f(aend - ab[3]));
              *(LAS u32x4*)(lds + O_X + off) = wd;
              *(LAS u32x4*)(lds + O_XW + off) = w; }
            if (c + 1 < 32) SCAN_LOAD(c + 1);
            LDS_BARRIER();
#define SCAN_BLOCK(YACC, sb, DIAG) do { \
                    f32x16 cb; \
                    _Pragma("unroll") for (int i = 0; i < 16; ++i) cb[i] = 0.f; \
                    _Pragma("unroll") for (int kh = 0; kh < 2; ++kh) { \
                        _Pragma("unroll") for (int ks = 0; ks < 4; ++ks) { fa[ks] = *(const LAS bf16x8*)(lds + O_B + ((32 * (sb) + r) * PT + 16 * (4 * kh + ks) + 8 * hi) * 2); \
                            fc[ks] = *(const LAS bf16x8*)(lds + O_C + (l * PT + 16 * (4 * kh + ks) + 8 * hi) * 2); } \
                        __builtin_amdgcn_sched_barrier(0); \
                        _Pragma("unroll") for (int ks = 0; ks < 4; ++ks) cb = MFMA32(fa[ks], fc[ks], cb); \
                    } \
                    _Pragma("unroll") for (int gq = 0; gq < 4; ++gq) { \
                        const int sbase = 32 * (sb) + 8 * gq + 4 * hi; \
                        const f32x4 acs = *(const LAS f32x4*)(s_ac + sbase); \
                        _Pragma("unroll") for (int q = 0; q < 4; ++q) { \
                            float v = cb[4 * gq + q] * __builtin_amdgcn_exp2f(acl - acs[q]); \
                            if (DIAG) { const int sidx = sbase + q; v = (sidx <= l) ? v : 0.f; if (sidx == l) v += dskip; } \
                            cb[4 * gq + q] = v; } \
                    } \
                    _Pragma("unroll") for (int ks2 = 0; ks2 < 2; ++ks2) { \
                        const bf16x8 pf = pack8(cb, ks2); \
                        const ldsp xa = lds + O_X + (r * PT + 32 * (sb) + 16 * ks2 + 4 * hi) * 2; \
                        const s16x4 lo = *(const LAS s16x4*)(xa), hh = *(const LAS s16x4*)(xa + 16); \
                        const bf16x8 xf = __builtin_shufflevector(lo, hh, 0, 1, 2, 3, 4, 5, 6, 7); \
                        YACC = MFMA32(xf, pf, YACC); } \
                } while (0)
            constexpr int O_PART = O_AC + 8 * 512;
            f32x16 ya;
#pragma unroll
            for (int i = 0; i < 16; ++i) ya[i] = 0.f;
            if (wave < 4) {
                const int lb = wave, l = 32 * lb + r; const float acl = s_ac[l];
                bf16x8 fa[4], fc[4];
#pragma unroll
                for (int kh = 0; kh < 2; ++kh) {
#pragma unroll
                    for (int ks = 0; ks < 4; ++ks) { fa[ks] = *(const LAS bf16x8*)(lds + O_S + (r * PT + 16 * (4 * kh + ks) + 8 * hi) * 2);
                        fc[ks] = *(const LAS bf16x8*)(lds + O_C + (l * PT + 16 * (4 * kh + ks) + 8 * hi) * 2); }
                    __builtin_amdgcn_sched_barrier(0);
#pragma unroll
                    for (int ks = 0; ks < 4; ++ks) ya = MFMA32(fa[ks], fc[ks], ya);
                }
                { const float e = __builtin_amdgcn_exp2f(acl);
#pragma unroll
                  for (int i = 0; i < 16; ++i) ya[i] *= e; }
                const float dskip = Dh * __builtin_amdgcn_rcpf(s_dt[l]);
                if (lb >= 1) SCAN_BLOCK(ya, lb - 1, false);
                SCAN_BLOCK(ya, lb, true);
            } else {
                const int nb = wave - 4; const float dec = __builtin_amdgcn_exp2f(s_ac[127]);
                {
#pragma unroll
                    for (int i = 0; i < 16; ++i) accS[i] *= dec;
#pragma unroll
                    for (int kh = 0; kh < 2; ++kh) {
                        bf16x8 fa[4], fb[4];
#pragma unroll
                        for (int ks = 0; ks < 4; ++ks) { fa[ks] = *(const LAS bf16x8*)(lds + O_XW + (r * PT + 16 * (4 * kh + ks) + 8 * hi) * 2);
                            fb[ks] = *(const LAS bf16x8*)(lds + O_BT + ((32 * nb + r) * PT + 16 * (4 * kh + ks) + 8 * hi) * 2); }
                        __builtin_amdgcn_sched_barrier(0);
#pragma unroll
                        for (int ks = 0; ks < 4; ++ks) accS = MFMA32(fa[ks], fb[ks], accS);
                    }
                }
                if (nb >= 2) {
                    const int l = 32 * nb + r; const float acl = s_ac[l]; const float dskip = 0.f; (void)dskip;
                    bf16x8 fa[4], fc[4];
                    for (int sb = 0; sb <= nb - 2; ++sb) SCAN_BLOCK(ya, sb, false);
#pragma unroll
                    for (int i = 0; i < 16; ++i) *(LAS float*)(lds + O_PART + (((nb - 2) * 16 + i) * 64 + lane) * 4) = ya[i];
                }
            }
#undef SCAN_BLOCK
            LDS_BARRIER();
            if (wave < 4) {
                const int lb = wave, l = 32 * lb + r;
                if (lb >= 2) {
#pragma unroll
                    for (int i = 0; i < 16; ++i) ya[i] += *(const LAS float*)(lds + O_PART + (((lb - 2) * 16 + i) * 64 + lane) * 4);
                }
                bf16_t* yp = Y + (size_t)(t0 + l) * DIN + h * 64 + ph * 32 + 4 * hi;
#pragma unroll
                for (int gq = 0; gq < 4; ++gq) { u32x2 w; w.x = pk2(ya[4 * gq], ya[4 * gq + 1]); w.y = pk2(ya[4 * gq + 2], ya[4 * gq + 3]); *(u32x2*)(yp + 8 * gq) = w; }
            } else { const int nb = wave - 4;
#pragma unroll
                for (int i = 0; i < 16; ++i) *(LAS bf16_t*)(lds + O_S + (crow(i, hi) * PT + 32 * nb + r) * 2) = f2bf(accS[i]); }
        }
#undef SCAN_LOAD
        __syncthreads();
    }
}

DI void gatenorm_phase(PPtr p, int wave, int lane) {
    const bf16_t* zx = (const bf16_t*)(p->ws + WS_ZX); const bf16_t* Y = (const bf16_t*)(p->ws + WS_Y); bf16_t* gn = (bf16_t*)(p->ws + WS_GN);
    const int gw = blockIdx.x * 8 + wave, ngw = gridDim.x * 8;
    for (int t0 = gw * 2; t0 < T; t0 += ngw * 2) {
        u32x4 yv[2][4], zv[2][4];
#pragma unroll
        for (int rr = 0; rr < 2; ++rr)
#pragma unroll
            for (int jg = 0; jg < 4; ++jg) { const int c = 8 * (lane + 64 * jg);
                yv[rr][jg] = *(const u32x4*)(Y + (size_t)(t0 + rr) * DIN + c); zv[rr][jg] = *(const u32x4*)(zx + (size_t)(t0 + rr) * ZXW + c); }
#pragma unroll
        for (int rr = 0; rr < 2; ++rr)
#pragma unroll
            for (int jg = 0; jg < 4; ++jg) {
                const int c = 8 * (lane + 64 * jg);
                float v[8]; float ss = 0.f;
#pragma unroll
                for (int i = 0; i < 4; ++i) { v[2 * i] = bflo(yv[rr][jg][i]) * silu_f(bflo(zv[rr][jg][i])); v[2 * i + 1] = bfhi(yv[rr][jg][i]) * silu_f(bfhi(zv[rr][jg][i])); ss += v[2 * i] * v[2 * i] + v[2 * i + 1] * v[2 * i + 1]; }
                const float rs = rsqrtf(wave_sum(ss) * (1.0f / 512.0f) + EPS);
                u32x4 w;
#pragma unroll
                for (int i = 0; i < 4; ++i) w[i] = pk2(v[2 * i] * rs, v[2 * i + 1] * rs);
                *(u32x4*)(gn + (size_t)(t0 + rr) * DIN + c) = w;
            }
    }
}

#define XB_TMO      128
#define XB_XCNT(j)  (256  + 64 * (j))
#define XB_XSUB(j)  (1280 + 64 * (j))
#define XB_XGEN(j)  (2304 + 64 * (j))
#define XB_TOP      3328
#define XB_TOPGEN   3392
#define XCD_BAR_WORDS 3456
#define XB_SPIN_CAP (1u << 22)
DI unsigned xb_ld(unsigned* p)              { return __hip_atomic_load(p, __ATOMIC_RELAXED, __HIP_MEMORY_SCOPE_AGENT); }
DI unsigned xb_add(unsigned* p, unsigned v) { return __hip_atomic_fetch_add(p, v, __ATOMIC_RELAXED, __HIP_MEMORY_SCOPE_AGENT); }
DI unsigned xb_xcc_id() { return (unsigned)__builtin_amdgcn_s_getreg((3 << 11) | 20) & 0xFu; }
#define XB_SPIN(cond, bar) do { unsigned _sp = 0; while (cond) { __builtin_amdgcn_s_sleep(1); \
    if ((++_sp & 255u) == 0u) { if (xb_ld(&(bar)[XB_TMO])) break; if (_sp > XB_SPIN_CAP) { atomicAdd(&(bar)[XB_TMO], 1u); break; } } } } while (0)
struct XcdBarrier { unsigned* bar; unsigned x; volatile LAS unsigned* st; };
DI XcdBarrier xcd_barrier_post(unsigned* bar, volatile LAS unsigned* st) {
    XcdBarrier b; b.bar = bar; b.x = xb_xcc_id(); b.st = st;
    if (threadIdx.x == 0) (void)xb_add(&bar[XB_XCNT(b.x)], 1u);
    return b;
}
DI void xcd_barrier_complete(unsigned* bar, unsigned x, unsigned& nloc, unsigned& nx) {
    const unsigned G = gridDim.x * gridDim.y * gridDim.z;
    unsigned sum, cnt, mine, sp = 0u;
    for (;;) {
        sum = 0u; cnt = 0u; mine = 0u;
#pragma unroll
        for (unsigned j = 0; j < 16; ++j) { const unsigned c = xb_ld(&bar[XB_XCNT(j)]); sum += c; cnt += (c > 0u) ? 1u : 0u; mine = (j == x) ? c : mine; }
        if (sum == G) break;
        __builtin_amdgcn_s_sleep(1);
        if ((++sp & 255u) == 0u) { if (xb_ld(&bar[XB_TMO])) break; if (sp > XB_SPIN_CAP) { atomicAdd(&bar[XB_TMO], 1u); break; } }
    }
    nloc = mine > 0u ? mine : 1u; nx = cnt > 0u ? cnt : 1u;
}
DI void xcd_barrier(unsigned* bar_, volatile LAS unsigned* st_) {
    XcdBarrier b; b.bar = bar_; b.st = st_; b.x = 0;
    asm volatile("s_waitcnt vmcnt(0)" ::: "memory");
    __syncthreads();
    if (threadIdx.x == 0) {
        unsigned* bar = b.bar; b.x = xb_xcc_id();
        __builtin_amdgcn_s_waitcnt(0);
        unsigned nloc = b.st[0], nx = b.st[1];
        if (nloc == 0u) { xcd_barrier_complete(bar, b.x, nloc, nx); b.st[0] = nloc; b.st[1] = nx; }
        const unsigned old = xb_add(&bar[XB_XSUB(b.x)], 1u);
        const unsigned gen = old / nloc;
        if (old + 1u == (gen + 1u) * nloc) {
            __builtin_amdgcn_fence(__ATOMIC_RELEASE, "agent");
            asm volatile("s_waitcnt vmcnt(0)" ::: "memory");
            const unsigned og = xb_add(&bar[XB_TOP], 1u);
            const unsigned tg = og / nx;
            if (og + 1u == (tg + 1u) * nx) xb_add(&bar[XB_TOPGEN], 1u);
            else XB_SPIN(xb_ld(&bar[XB_TOPGEN]) == tg, bar);
            __builtin_amdgcn_fence(__ATOMIC_ACQUIRE, "agent");
            xb_add(&bar[XB_XGEN(b.x)], 1u);
            asm volatile("s_waitcnt vmcnt(0)" ::: "memory");
        } else {
            XB_SPIN(xb_ld(&bar[XB_XGEN(b.x)]) == gen, bar);
            __builtin_amdgcn_fence(__ATOMIC_ACQUIRE, "agent");
            asm volatile("s_waitcnt vmcnt(0)" ::: "memory");
        }
    }
    __syncthreads();
}

__global__ void __launch_bounds__(512, 2) mega_fwd(Params pv) {
    extern __shared__ __attribute__((aligned(16))) unsigned char lds_raw[];
    ldsp lds = (ldsp)lds_raw;
    PPtr p = (PPtr)__builtin_amdgcn_kernarg_segment_ptr();
    cg::grid_group grid = cg::this_grid();
    constexpr int BAR_LDS_OFF = LDS_BYTES - 64;
    if (threadIdx.x < 16) ((LAS unsigned*)(lds + BAR_LDS_OFF))[threadIdx.x] = 0u;
    __syncthreads();
    (void)xcd_barrier_post((unsigned*)(p->ws + WS_CTL), (volatile LAS unsigned*)(lds + BAR_LDS_OFF));
#define GRID_SYNC() do { FRESH(p); xcd_barrier((unsigned*)(p->ws + WS_CTL), (volatile LAS unsigned*)(lds + BAR_LDS_OFF)); FRESH(p); } while (0)
#define mods ((const float*)(p->ws + WS_MODS))
#define hbuf ((bf16_t*)(p->ws + WS_H))

    { PHASE_IDS(); phase0(p, lds, tid, wave, lane); }
    if (p->out == nullptr) grid.sync();
    GRID_SYNC();

#pragma unroll 1
    for (int layer = 0; layer < DEPTH; ++layer) {
        const int j = layer >> 1;
#pragma unroll 1
        for (int sub = 0; sub < 3; ++sub) {
            const float* xin = (layer == 0 && sub == 0) ? p->x : p->out;
            const float* mods_ls = mods + (size_t)(layer * 36 + sub * 3) * 1024;
            const int qs = layer * 3 + sub;
            const bool fuse_norm = FUSE_NORM && (gridDim.x == 256);
            if (qs == 0 || !fuse_norm) {
                { PHASE_IDS(); norm_phase(xin, p->norm_gain + (size_t)(layer * 3 + sub) * DM, mods_ls, hbuf, wave, lane); }
                GRID_SYNC();
            }
            pg8::Gemm rg; float gs;
            if (sub != 1) {
                const int fi = layer * 2 + (sub == 2 ? 1 : 0);
                pg8::Gemm g{hbuf, (const bf16_t*)(p->ws + WS_WGU + fi * SZ_WGU), T, 2 * DFF, DM, DM};
                pg8::StaticOrder S; S.init(T, 2 * DFF, gridDim.x, opaque_bid());
                pg8::EpiSwiGLU E{(bf16_t*)(p->ws + WS_ACT)};
                REP(1) { pg8::gemm_phase<pg8::EpiSwiGLU>(lds, g, S, E);
                GRID_SYNC(); }
                rg = pg8::Gemm{(const bf16_t*)(p->ws + WS_ACT), (const bf16_t*)(p->ws + WS_WDN + fi * SZ_WDN), T, DM, DFF, DFF}; gs = 0.5f;
            } else {
                const bool mla = (layer & 1) == 0;
                const int nrounds = mla ? 2 : 1;
#pragma unroll 1
                for (int round = 0; round < nrounds; ++round) REP(32) {
                    const int njobs = (mla && round == 1) ? 2 : 1;
#pragma unroll 1
                    for (int job = 0; job < njobs; ++job) {
                        pg8::Gemm g; pg8::EpiStore E;
                        if (!mla) { g = pg8::Gemm{hbuf, (const bf16_t*)(p->ws + WS_WIN + j * SZ_WIN), T, ZXW, DM, DM}; E = pg8::EpiStore{(bf16_t*)(p->ws + WS_ZX), ZXW, ZXW, nullptr}; }
                        else if (round == 0) { g = pg8::Gemm{hbuf, (const bf16_t*)(p->ws + WS_WA + j * SZ_WA), T, ADIMP, DM, DM}; E = pg8::EpiStore{(bf16_t*)(p->ws + WS_AOUT), ADIMP, ADIMP, nullptr}; }
                        else if (job == 0) { g = pg8::Gemm{(const bf16_t*)(p->ws + WS_AOUT), (const bf16_t*)(p->ws + WS_WQB + j * SZ_WQB), T, 1536, QL, ADIMP}; E = pg8::EpiStore{(bf16_t*)(p->ws + WS_QRAW), 1536, 1536, nullptr}; }
                        else { g = pg8::Gemm{(const bf16_t*)(p->ws + WS_AOUT) + QL, (const bf16_t*)(p->ws + WS_WKVB + j * SZ_WKVB), T, 2048, KVL, ADIMP}; E = pg8::EpiStore{(bf16_t*)(p->ws + WS_KVRAW), 2048, 2048, nullptr}; }
                        pg8::StaticOrder S; S.init(T, g.N, gridDim.x, opaque_bid());
                        pg8::gemm_phase<pg8::EpiStore>(lds, g, S, E);
                    }
                    GRID_SYNC();
                }
                if (mla) {
                    REP(16) { { PHASE_IDS(); mla_finalize(p, j, lds, tid, wave, lane); }
                    GRID_SYNC(); }
                    REP(2) { { PHASE_IDS(); attn_phase(p, j, lds, tid, wave, lane); }
                    GRID_SYNC(); }
                    rg = pg8::Gemm{(const bf16_t*)(p->ws + WS_O), (const bf16_t*)(p->ws + WS_WO + j * SZ_WO), T, DM, DM, DM}; gs = 1.0f;
                } else {
                    REP(16) { { PHASE_IDS(); conv_phase(p, j, lds, tid); }
                    GRID_SYNC(); }
                    REP(4) { { PHASE_IDS(); scan_phase(p, j, lds, tid, wave, lane); }
                    GRID_SYNC(); }
                    REP(16) { { PHASE_IDS(); gatenorm_phase(p, wave, lane); }
                    GRID_SYNC(); }
                    rg = pg8::Gemm{(const bf16_t*)(p->ws + WS_GN), (const bf16_t*)(p->ws + WS_WOUT + j * SZ_WOUT), T, DM, DIN, DIN}; gs = 1.0f;
                }
            }
            {
                pg8::StaticOrder S; S.init(T, DM, gridDim.x, opaque_bid());
                const bool has_next = qs < 11; const int qn = has_next ? qs + 1 : 0, ln = qn / 3, sn = qn % 3;
                pg8::EpiRes E{xin, p->out, mods_ls + 2048, hbuf, p->norm_gain + (size_t)qn * DM, mods + (size_t)(ln * 36 + sn * 3) * 1024,
                              (float*)(p->ws + WS_ROWSS), (unsigned*)(p->ws + WS_CTL) + 8192, gs, (has_next && fuse_norm) ? 1 : 0, 32u * (unsigned)(qs + 1), 0};
                pg8::gemm_phase<pg8::EpiRes, false>(lds, rg, S, E);
            }
            if (qs < 11) GRID_SYNC();
        }
    }
}

extern "C" void kernel_launch(void* const* d_in, const int* in_sizes, int n_in, void* d_out, int out_size, void* d_ws, size_t ws_size, hipStream_t stream) {
    static int grid = 0;
    if (grid == 0) {
        if (n_in != 24 || out_size != T * DM || ws_size < WS_END) { fprintf(stderr, "kernel_launch: unexpected shapes (n_in %d, out %d, ws %zu, need %zu)\n", n_in, out_size, ws_size, (size_t)WS_END); grid = -1; return; }
        int dev = 0, cus = 0, per_cu = 0;
        (void)hipGetDevice(&dev);
        (void)hipDeviceGetAttribute(&cus, hipDeviceAttributeMultiprocessorCount, dev);
        (void)hipFuncSetAttribute((const void*)mega_fwd, hipFuncAttributeMaxDynamicSharedMemorySize, LDS_BYTES);
        (void)hipOccupancyMaxActiveBlocksPerMultiprocessor(&per_cu, (const void*)mega_fwd, 512, LDS_BYTES);
        if (per_cu < 1) { fprintf(stderr, "kernel_launch: occupancy query says %d blocks per CU\n", per_cu); per_cu = 1; }
        (void)hipGetLastError();
        grid = cus;
    }
    if (grid < 0) return;
    (void)hipMemsetAsync((unsigned char*)d_ws + WS_CTL, 0, FUSE_NORM ? 65536 : 16384, stream);
    Params hp{};
        hp.x = (const float*)d_in[0]; hp.c = (const float*)d_in[1]; hp.pos = (const int*)d_in[2];
    hp.norm_gain = (const float*)d_in[3]; hp.ada_w = (const float*)d_in[4]; hp.ada_b = (const float*)d_in[5];
    hp.ffn_w_gu = (const float*)d_in[6]; hp.ffn_w_down = (const float*)d_in[7];
    hp.mla_w_a = (const float*)d_in[8]; hp.mla_q_a_gain = (const float*)d_in[9]; hp.mla_kv_a_gain = (const float*)d_in[10];
    hp.mla_w_qb = (const float*)d_in[11]; hp.mla_w_kvb = (const float*)d_in[12]; hp.mla_q_gain = (const float*)d_in[13];
    hp.mla_k_gain = (const float*)d_in[14]; hp.mla_w_o = (const float*)d_in[15];
    hp.ssd_w_in = (const float*)d_in[16]; hp.ssd_conv_w = (const float*)d_in[17]; hp.ssd_conv_b = (const float*)d_in[18];
    hp.ssd_dt_bias = (const float*)d_in[19]; hp.ssd_a_log = (const float*)d_in[20]; hp.ssd_d = (const float*)d_in[21];
    hp.ssd_norm_gain = (const float*)d_in[22]; hp.ssd_w_out = (const float*)d_in[23];
    hp.out = (float*)d_out; hp.ws = (unsigned char*)d_ws;
    void* args[] = {&hp};
    hipError_t e = hipLaunchCooperativeKernel((const void*)mega_fwd, dim3(grid), dim3(512), args, LDS_BYTES, stream);
    if (e != hipSuccess) fprintf(stderr, "kernel_launch: cooperative launch failed: %s (grid %d)\n", hipGetErrorString(e), grid);
}
```

```cpp
#include <hip/hip_runtime.h>
#include <hip/hip_cooperative_groups.h>
#include <cstdio>
#include <cstdint>
#include <cmath>
namespace cg = cooperative_groups;

#define LAS __attribute__((address_space(3)))
#define DI __device__ __forceinline__
typedef unsigned short bf16_t;
typedef short bf16x8 __attribute__((ext_vector_type(8)));
typedef short s16x4 __attribute__((ext_vector_type(4)));
typedef float f32x4 __attribute__((ext_vector_type(4)));
typedef float f32x2 __attribute__((ext_vector_type(2)));
typedef float f32x16 __attribute__((ext_vector_type(16)));
typedef unsigned u32x4 __attribute__((ext_vector_type(4)));
typedef unsigned u32x2 __attribute__((ext_vector_type(2)));
typedef __bf16 bf16x2_t __attribute__((ext_vector_type(2)));
typedef LAS unsigned char* ldsp;

constexpr int DM = 1024, NBATCH = 4, SEQ = 4096, T = NBATCH * SEQ, DEPTH = 4;
constexpr int DFF = 2816;
constexpr int HEADS = 16, QL = 384, KVL = 256, QKH = 96, ADIM = 672, ADIMP = 768;
constexpr int DIN = 2048, SSDH = 32, INP = 5152, INPP = 5376, ZXW = 5120, CONVD = 3072;
constexpr float EPS = 1e-6f;
constexpr float QSCALE = 0.10206207261596577f * 1.4426950408889634f;

constexpr size_t MiB = 1u << 20;
constexpr size_t WS_CTL = 0;
constexpr size_t WS_MODS = 1 * MiB;
constexpr size_t WS_ROWSS = 4 * MiB;
constexpr size_t WS_BIAS = 2 * MiB;
constexpr int NBIAS = 5632;
static_assert(WS_BIAS + (size_t)12 * 4 * NBIAS * 4 <= WS_ROWSS && WS_ROWSS + (size_t)T * 16 * 4 <= 6 * MiB, "ws map");
constexpr size_t WS_WGU = 6 * MiB;
constexpr size_t SZ_WGU = (size_t)5632 * 1024 * 2;
constexpr size_t WS_WDN = WS_WGU + 8 * SZ_WGU;
constexpr size_t SZ_WDN = (size_t)1024 * 2816 * 2;
constexpr size_t WS_WA = WS_WDN + 8 * SZ_WDN;
constexpr size_t SZ_WA = (size_t)ADIMP * 1024 * 2;
constexpr size_t WS_WQB = WS_WA + 2 * SZ_WA;
constexpr size_t SZ_WQB = (size_t)1536 * 384 * 2;
constexpr size_t WS_WKVB = WS_WQB + 2 * SZ_WQB;
constexpr size_t SZ_WKVB = (size_t)2048 * 256 * 2;
constexpr size_t WS_WO = WS_WKVB + 2 * SZ_WKVB;
constexpr size_t SZ_WO = (size_t)1024 * 1024 * 2;
constexpr size_t WS_WIN = WS_WO + 2 * SZ_WO;
constexpr size_t SZ_WIN = (size_t)INPP * 1024 * 2;
constexpr size_t WS_WOUT = WS_WIN + 2 * SZ_WIN;
constexpr size_t SZ_WOUT = (size_t)1024 * 2048 * 2;
constexpr size_t WS_H = WS_WOUT + 2 * SZ_WOUT;
constexpr size_t WS_SCR = WS_H + (size_t)T * 1024 * 2;
constexpr size_t WS_ACT = WS_SCR;
constexpr size_t WS_AOUT = WS_SCR;
constexpr size_t WS_QRAW = WS_AOUT + (size_t)T * ADIMP * 2;
constexpr size_t WS_KVRAW = WS_QRAW + (size_t)T * 1536 * 2;
constexpr size_t WS_QB = WS_KVRAW + (size_t)T * 2048 * 2;
constexpr size_t WS_KB = WS_QB + (size_t)T * 1536 * 2;
constexpr size_t WS_VT = WS_KB + (size_t)T * 1536 * 2;
constexpr size_t WS_O = WS_VT + (size_t)T * 1024 * 2;
constexpr size_t WS_MLA_END = WS_O + (size_t)T * 1024 * 2;
constexpr size_t WS_ZX = WS_SCR;
constexpr size_t WS_DTRAW = WS_ZX + (size_t)T * ZXW * 2;
constexpr size_t WS_XT = WS_DTRAW + (size_t)T * 32 * 4;
constexpr size_t WS_GN = WS_XT;
constexpr size_t WS_BC = WS_XT + (size_t)T * 2048 * 2;
constexpr size_t WS_CC = WS_BC + (size_t)T * 512 * 2;
constexpr size_t WS_BT = WS_CC + (size_t)T * 512 * 2;
constexpr size_t WS_Y = WS_BT + (size_t)T * 512 * 2;
constexpr size_t WS_SSD_END = WS_Y + (size_t)T * 2048 * 2;
constexpr size_t WS_END = (WS_SSD_END > WS_MLA_END ? WS_SSD_END : WS_MLA_END);

constexpr int LDS_BYTES = 147456;
constexpr bool FUSE_NORM = false;
#ifndef DUP
#define DUP 0
#endif
#define REP(mask) _Pragma("unroll 1") for (int rep_ = 0; rep_ < ((DUP & (mask)) ? 2 : 1); ++rep_)

struct Params {
    const float* x; const float* c; const int* pos; const float* norm_gain; const float* ada_w; const float* ada_b;
    const float* ffn_w_gu; const float* ffn_w_down;
    const float* mla_w_a; const float* mla_q_a_gain; const float* mla_kv_a_gain; const float* mla_w_qb; const float* mla_w_kvb;
    const float* mla_q_gain; const float* mla_k_gain; const float* mla_w_o;
    const float* ssd_w_in; const float* ssd_conv_w; const float* ssd_conv_b; const float* ssd_dt_bias; const float* ssd_a_log;
    const float* ssd_d; const float* ssd_norm_gain; const float* ssd_w_out;
    float* out; unsigned char* ws;
};

typedef const __attribute__((address_space(4))) Params* PPtr;
#define FRESH(p) asm volatile("" : "+s"(p))
DI unsigned pk2(float lo, float hi) { f32x2 v = {lo, hi}; bf16x2_t b = __builtin_convertvector(v, bf16x2_t); return __builtin_bit_cast(unsigned, b); }
DI bf16_t f2bf(float v) { return (bf16_t)(pk2(v, 0.f) & 0xffffu); }
DI float bflo(unsigned w) { return __uint_as_float(w << 16); }
DI float bfhi(unsigned w) { return __uint_as_float(w & 0xffff0000u); }
DI int opaque_tid() { int t = threadIdx.x; asm volatile("" : "+v"(t)); return t; }
DI int opaque_bid() { int t = blockIdx.x; asm volatile("" : "+s"(t)); return t; }
#define PHASE_IDS() const int tid = opaque_tid(), lane = tid & 63, wave = __builtin_amdgcn_readfirstlane(tid >> 6); (void)lane; (void)wave
#define LDS_BARRIER() do { asm volatile("s_waitcnt lgkmcnt(0)" ::: "memory"); __builtin_amdgcn_s_barrier(); asm volatile("" ::: "memory"); } while (0)
DI float wave_sum(float v) {
#pragma unroll
    for (int o = 1; o < 64; o <<= 1) v += __shfl_xor(v, o);
    return v;
}
DI float silu_f(float g) { return g * __builtin_amdgcn_rcpf(1.0f + __expf(-g)); }
DI int crow(int reg, int h) { return (reg & 3) + 8 * (reg >> 2) + 4 * h; }
#define MFMA32(a, b, c) __builtin_amdgcn_mfma_f32_32x32x16_bf16((a), (b), (c), 0, 0, 0)
DI bf16x8 pack8(const f32x16& x, int s) {
    u32x4 p;
    p[0] = pk2(x[8 * s + 0], x[8 * s + 1]); p[1] = pk2(x[8 * s + 2], x[8 * s + 3]);
    p[2] = pk2(x[8 * s + 4], x[8 * s + 5]); p[3] = pk2(x[8 * s + 6], x[8 * s + 7]);
    return __builtin_bit_cast(bf16x8, p);
}

namespace pg8 {
constexpr int BM = 256, BK = 64, HALF = 128, HTB = HALF * BK * 2, STAGE_BYTES = 8 * HTB, NXCD = 8, WGM = 8;
DI int lds_byte(int r, int c) { const int st = (r >> 4) * 2 + (c >> 5), rr = r & 15, cc = c & 31, ob = rr * 64 + cc * 2; return st * 1024 + (ob ^ (((ob >> 9) & 1) << 5)); }
DI void stage_rc(int b, int& R, int& C) { const int st = b / 1024, sb = b % 1024, swz = sb ^ (((sb >> 9) & 1) << 5); R = (st >> 1) * 16 + swz / 64; C = (st & 1) * 32 + (swz % 64) / 2; }
DI int perm32(int rho) { const int n = rho >> 4, i = rho & 15; return 8 * (i >> 2) + 4 * n + (i & 3); }

struct Unit { int pm, pn; };
struct Gemm { const bf16_t* A; const bf16_t* Bt; int M, N, K, lda; };

struct StaticOrder {
    int nM, nN, nwg, G, c;
    DI void init(int M, int N, int G_, int c_) { nM = M / BM; nN = N / BM; nwg = nM * nN; G = G_; c = c_; }
    DI bool next(int i, Unit& u) const {
        const long L = (long)i * G + c; if (L >= nwg) return false;
        int wgid = (int)L; { const int q = nwg / NXCD, r = nwg % NXCD, xcd = wgid % NXCD, off = wgid / NXCD; wgid = (xcd < r ? xcd * (q + 1) : r * (q + 1) + (xcd - r) * q) + off; }
        const int nig = WGM * nN, gid = wgid / nig, fm = gid * WGM, gsz = (nM - fm) < WGM ? (nM - fm) : WGM;
        u.pm = fm + ((wgid % nig) % gsz); u.pn = (wgid % nig) / gsz; return true;
    }
};

struct EpiSwiGLU {
    static constexpr bool PERM = true;
    bf16_t* O;
    DI void operator()(const f32x4 (&acc)[2][2][4][2], const Unit& u, int wr, int wc, int fr, int fq) const {
        const int row0 = u.pm * BM + wr * 64 + fr; const int col0 = (u.pn * BM + wc * 32 + 8 * fq) >> 1;
#pragma unroll
        for (int ai = 0; ai < 2; ++ai)
#pragma unroll
            for (int m = 0; m < 4; ++m) { bf16_t* rowp = O + (size_t)(row0 + ai * HALF + m * 16) * DFF + col0;
#pragma unroll
                for (int bj = 0; bj < 2; ++bj) { const f32x4 v0 = acc[ai][bj][m][0], v1 = acc[ai][bj][m][1];
                    u32x2 w; w.x = pk2(silu_f(v0[0]) * v0[1], silu_f(v0[2]) * v0[3]); w.y = pk2(silu_f(v1[0]) * v1[1], silu_f(v1[2]) * v1[3]);
                    *(u32x2*)(rowp + bj * 64) = w; } }
    }
};
struct EpiStore {
    static constexpr bool PERM = true;
    bf16_t* O; int ldc; int nbf; float* dt;
    DI void operator()(const f32x4 (&acc)[2][2][4][2], const Unit& u, int wr, int wc, int fr, int fq) const {
        const int row0 = u.pm * BM + wr * 64 + fr; const int c0 = u.pn * BM + wc * 32 + 8 * fq;
#pragma unroll
        for (int ai = 0; ai < 2; ++ai)
#pragma unroll
            for (int m = 0; m < 4; ++m) { const int row = row0 + ai * HALF + m * 16;
#pragma unroll
                for (int bj = 0; bj < 2; ++bj) { const int c = c0 + bj * HALF; const f32x4 v0 = acc[ai][bj][m][0], v1 = acc[ai][bj][m][1];
                    if (c < nbf) { u32x4 w; w.x = pk2(v0[0], v0[1]); w.y = pk2(v0[2], v0[3]); w.z = pk2(v1[0], v1[1]); w.w = pk2(v1[2], v1[3]);
                        *(u32x4*)(O + (size_t)row * ldc + c) = w; }
                    else if (dt != nullptr && c < nbf + 32) { float* d = dt + (size_t)row * 32 + (c - nbf); *(f32x4*)d = v0; *(f32x4*)(d + 4) = v1; } } }
    }
};
struct EpiRes {
    static constexpr bool PERM = false;
    const float* xin; float* xout; const float* gate; bf16_t* xb; const float* gain_n; const float* mods_n; float* slots; unsigned* cnt; float gs; int fused; unsigned expect; int pad_;
    DI void operator()(f32x4 (&acc)[2][2][4][2], const Unit& u, int wr, int wc, int fr, int fq) const {
        const int col0 = u.pn * BM + wc * 32 + 4 * fq; const float* g = gate + (size_t)(u.pm >> 4) * 9216;
        {
            f32x4 gv[2][2];
#pragma unroll
            for (int bj = 0; bj < 2; ++bj)
#pragma unroll
                for (int n = 0; n < 2; ++n) gv[bj][n] = *(const f32x4*)(g + col0 + bj * HALF + n * 16) * gs;
#pragma unroll
            for (int ai = 0; ai < 2; ++ai)
#pragma unroll
                for (int m = 0; m < 4; ++m) { const int row = u.pm * BM + ai * HALF + wr * 64 + m * 16 + fr; const size_t off = (size_t)row * DM + col0;
                    float sq = 0.f;
#pragma unroll
                    for (int bj = 0; bj < 2; ++bj)
#pragma unroll
                        for (int n = 0; n < 2; ++n) { const f32x4 xi = *(const f32x4*)(xin + off + bj * HALF + n * 16);
                            const f32x4 o = xi + gv[bj][n] * acc[ai][bj][m][n];
                            if (!fused) *(f32x4*)(xout + off + bj * HALF + n * 16) = o;
                            acc[ai][bj][m][n] = o;
                            sq += (o[0] * o[0] + o[1] * o[1]) + (o[2] * o[2] + o[3] * o[3]); }
                    if (fused) { sq += __shfl_xor(sq, 16); sq += __shfl_xor(sq, 32);
                        if (fq == 0) __hip_atomic_store(slots + (size_t)row * 16 + u.pn * 4 + wc, sq, __ATOMIC_RELAXED, __HIP_MEMORY_SCOPE_AGENT); }
                    if (m & 1) asm volatile("" ::: "memory"); }
        }
        if (!fused) return;
        asm volatile("s_waitcnt vmcnt(0)" ::: "memory");
        unsigned* c = cnt + 64 * u.pm;
        if (fr == 0 && fq == 0) __hip_atomic_fetch_add(c, 1u, __ATOMIC_RELAXED, __HIP_MEMORY_SCOPE_AGENT);
#pragma unroll
        for (int ai = 0; ai < 2; ++ai)
#pragma unroll
            for (int m = 0; m < 4; ++m) { const size_t off = (size_t)(u.pm * BM + ai * HALF + wr * 64 + m * 16 + fr) * DM + col0;
#pragma unroll
                for (int bj = 0; bj < 2; ++bj)
#pragma unroll
                    for (int n = 0; n < 2; ++n) *(f32x4*)(xout + off + bj * HALF + n * 16) = acc[ai][bj][m][n]; }
        if (fr == 0 && fq == 0) {
            unsigned it = 0;
            while (__hip_atomic_load(c, __ATOMIC_RELAXED, __HIP_MEMORY_SCOPE_AGENT) < expect && ++it < (1u << 21)) __builtin_amdgcn_s_sleep(2);
        }
        asm volatile("" ::: "memory");
        const float* sh = mods_n + (size_t)(u.pm >> 4) * 9216;
        f32x4 gsc[2][2], shv[2][2];
#pragma unroll
        for (int bj = 0; bj < 2; ++bj)
#pragma unroll
            for (int n = 0; n < 2; ++n) { const int c4 = col0 + bj * HALF + n * 16;
                gsc[bj][n] = *(const f32x4*)(gain_n + c4) * (*(const f32x4*)(sh + 1024 + c4) + 1.0f); shv[bj][n] = *(const f32x4*)(sh + c4); }
#pragma unroll
        for (int ai = 0; ai < 2; ++ai)
#pragma unroll
            for (int m = 0; m < 4; ++m) { const int row = u.pm * BM + ai * HALF + wr * 64 + m * 16 + fr; const size_t off = (size_t)row * DM + col0;
                const float* sp = slots + (size_t)row * 16 + 4 * fq;
                float t = (__hip_atomic_load(sp, __ATOMIC_RELAXED, __HIP_MEMORY_SCOPE_AGENT) + __hip_atomic_load(sp + 1, __ATOMIC_RELAXED, __HIP_MEMORY_SCOPE_AGENT))
                        + (__hip_atomic_load(sp + 2, __ATOMIC_RELAXED, __HIP_MEMORY_SCOPE_AGENT) + __hip_atomic_load(sp + 3, __ATOMIC_RELAXED, __HIP_MEMORY_SCOPE_AGENT));
                t += __shfl_xor(t, 16); t += __shfl_xor(t, 32);
                const float rs = rsqrtf(t * (1.0f / DM) + EPS);
#pragma unroll
                for (int bj = 0; bj < 2; ++bj)
#pragma unroll
                    for (int n = 0; n < 2; ++n) { const f32x4 hv = acc[ai][bj][m][n] * rs * gsc[bj][n] + shv[bj][n];
                        u32x2 w; w.x = pk2(hv[0], hv[1]); w.y = pk2(hv[2], hv[3]); *(u32x2*)(xb + off + bj * HALF + n * 16) = w; } }
    }
};

template <class Epi>
DI void gemm_phase(ldsp lds, const Gemm g, const StaticOrder S, const Epi E) {
    const int tid = opaque_tid(), wid = __builtin_amdgcn_readfirstlane(tid >> 6), lane = tid & 63, wr = wid >> 2, wc = wid & 3, fr = lane & 15, fq = lane >> 4;
    const int K = g.K, nt = K / BK, lda = g.lda;
    unsigned voffA[2], voffB[2];
#pragma unroll
    for (int i = 0; i < 2; ++i) { int R, C; stage_rc(tid * 16 + i * 8192, R, C); const int Rb = Epi::PERM ? ((R & ~31) + perm32(R & 31)) : R;
        voffA[i] = (unsigned)(R * lda + C) * 2u; voffB[i] = (unsigned)(Rb * K + C) * 2u; }
    const size_t kstep = (size_t)(BK * 2);
    const size_t hstepA = (size_t)HALF * lda * 2, hstepB = (size_t)HALF * K * 2;
    const size_t tstepA = 2 * hstepA, tstepB = 2 * hstepB;
    const unsigned ldsw = (unsigned)wid * 1024u;
    const int aoff = lds_byte(wr * 64 + fr, fq * 8), boff = lds_byte(wc * 32 + fr, fq * 8);
#define PG8_SA(b, h) (((b) * 2 + (h)) * HTB)
#define PG8_SB(b, h) ((4 + (b) * 2 + (h)) * HTB)
#define PG8_STAGE(bufoff, gbase, voff) do { _Pragma("unroll") for (int _i = 0; _i < 2; ++_i) \
        __builtin_amdgcn_global_load_lds((const unsigned*)((const char*)(gbase) + (voff)[_i]), (LAS unsigned*)(lds + (bufoff) + ldsw + _i * 8192), 16, 0, 0); } while (0)
#define PG8_LDA(dst, b, h) do { _Pragma("unroll") for (int m = 0; m < 4; ++m) _Pragma("unroll") for (int k = 0; k < 2; ++k) dst[m][k] = *(const LAS bf16x8*)(lds + PG8_SA(b, h) + aoff + m * 2048 + k * 1024); } while (0)
#define PG8_LDB(dst, b, h) do { _Pragma("unroll") for (int n = 0; n < 2; ++n) _Pragma("unroll") for (int k = 0; k < 2; ++k) dst[n][k] = *(const LAS bf16x8*)(lds + PG8_SB(b, h) + boff + n * 2048 + k * 1024); } while (0)
#define PG8_MMA(ai, bj, At, Bt) do { __builtin_amdgcn_s_setprio(1); _Pragma("unroll") for (int m = 0; m < 4; ++m) _Pragma("unroll") for (int n = 0; n < 2; ++n) _Pragma("unroll") for (int k = 0; k < 2; ++k) \
        acc[ai][bj][m][n] = __builtin_amdgcn_mfma_f32_16x16x32_bf16(Bt[n][k], At[m][k], acc[ai][bj][m][n], 0, 0, 0); __builtin_amdgcn_s_setprio(0); } while (0)
#define PG8_WAIT_V(n) asm volatile("s_waitcnt vmcnt(" #n ")" ::: "memory")
#define PG8_WAIT_L(n) asm volatile("s_waitcnt lgkmcnt(" #n ")" ::: "memory")
#define PG8_BAR __builtin_amdgcn_s_barrier()
#define PG8_SCHED __builtin_amdgcn_sched_barrier(0)
    Unit cur, nxt; int ui = 0;
    if (!S.next(0, cur)) return;
    f32x4 acc[2][2][4][2];
#pragma unroll
    for (int a = 0; a < 2; ++a)
#pragma unroll
        for (int b = 0; b < 2; ++b)
#pragma unroll
            for (int m = 0; m < 4; ++m)
#pragma unroll
                for (int n = 0; n < 2; ++n) acc[a][b][m][n] = (f32x4){0.f, 0.f, 0.f, 0.f};
    bf16x8 At[4][2], B0[2][2], B1[2][2];
    const char* cA = (const char*)g.A + (size_t)cur.pm * tstepA; const char* cB = (const char*)g.Bt + (size_t)cur.pn * tstepB;
    PG8_STAGE(PG8_SB(0, 0), cB, voffB); PG8_STAGE(PG8_SB(0, 1), cB + hstepB, voffB); PG8_STAGE(PG8_SA(0, 0), cA, voffA); PG8_STAGE(PG8_SA(0, 1), cA + hstepA, voffA);
    if (wr == 1) PG8_BAR;
    PG8_WAIT_V(2); PG8_BAR;
    PG8_STAGE(PG8_SB(1, 0), cB + kstep, voffB); PG8_STAGE(PG8_SA(1, 0), cA + kstep, voffA); PG8_STAGE(PG8_SB(1, 1), cB + hstepB + kstep, voffB);
    PG8_WAIT_V(6); PG8_BAR;
    for (;;) {
        const bool has_next = S.next(ui + 1, nxt);
        const char* nA = has_next ? (const char*)g.A + (size_t)nxt.pm * tstepA : cA; const char* nB = has_next ? (const char*)g.Bt + (size_t)nxt.pn * tstepB : cB;
        for (int t = 0; t < nt; t += 2) {
            const bool last = (t == nt - 2);
            const char* a1 = cA + (size_t)(t + 1) * kstep;
            const char* a2 = last ? nA : cA + (size_t)(t + 2) * kstep; const char* b2 = last ? nB : cB + (size_t)(t + 2) * kstep;
            const char* a3 = a2 + kstep; const char* b3 = b2 + kstep;
            PG8_LDB(B0, 0, 0); PG8_LDB(B1, 0, 1); PG8_SCHED; PG8_LDA(At, 0, 0); PG8_STAGE(PG8_SA(1, 1), a1 + hstepA, voffA);
            PG8_WAIT_V(8); PG8_WAIT_L(0); PG8_BAR; PG8_MMA(0, 0, At, B0); PG8_MMA(0, 1, At, B1); PG8_BAR; PG8_SCHED;
            PG8_LDA(At, 0, 1); PG8_STAGE(PG8_SB(0, 0), b2, voffB); PG8_STAGE(PG8_SB(0, 1), b2 + hstepB, voffB); PG8_STAGE(PG8_SA(0, 0), a2, voffA);
            PG8_WAIT_V(8); PG8_WAIT_L(0); PG8_BAR; PG8_MMA(1, 0, At, B0); PG8_MMA(1, 1, At, B1); PG8_BAR; PG8_SCHED;
            PG8_LDB(B0, 1, 0); PG8_LDB(B1, 1, 1); PG8_SCHED; PG8_LDA(At, 1, 0); PG8_STAGE(PG8_SA(0, 1), a2 + hstepA, voffA);
            PG8_WAIT_V(8); PG8_WAIT_L(0); PG8_BAR; PG8_MMA(0, 0, At, B0); PG8_MMA(0, 1, At, B1); PG8_BAR; PG8_SCHED;
            PG8_LDA(At, 1, 1); PG8_STAGE(PG8_SB(1, 0), b3, voffB); PG8_STAGE(PG8_SB(1, 1), b3 + hstepB, voffB); PG8_STAGE(PG8_SA(1, 0), a3, voffA);
            PG8_WAIT_V(8); PG8_WAIT_L(0); PG8_BAR; PG8_MMA(1, 0, At, B0); PG8_MMA(1, 1, At, B1); PG8_BAR; PG8_SCHED;
        }
        if (wr == 0) PG8_BAR;
        E(acc, cur, wr, wc, fr, fq);
        if (!has_next) break;
#pragma unroll
        for (int a = 0; a < 2; ++a)
#pragma unroll
            for (int b = 0; b < 2; ++b)
#pragma unroll
                for (int m = 0; m < 4; ++m)
#pragma unroll
                    for (int n = 0; n < 2; ++n) acc[a][b][m][n] = (f32x4){0.f, 0.f, 0.f, 0.f};
        cur = nxt; cA = nA; cB = nB; ++ui;
        if (wr == 1) PG8_BAR;
    }
    PG8_WAIT_V(0);
    PG8_BAR;
#undef PG8_SA
#undef PG8_SB
#undef PG8_STAGE
#undef PG8_LDA
#undef PG8_LDB
#undef PG8_MMA
#undef PG8_WAIT_V
#undef PG8_WAIT_L
#undef PG8_BAR
#undef PG8_SCHED
}
}

DI void cvt_item(const float* W, int K, int N, bf16_t* WT, const float* kgain, int half, LAS float* scr, int item, int lane) {
    const int nblk = N / 32, kb = item / nblk, nb = item % nblk, k0 = 64 * kb, n0 = 32 * nb;
    const int kq = lane >> 3, nq = lane & 7;
    f32x4 v[8];
#pragma unroll
    for (int i = 0; i < 8; ++i) v[i] = *(const f32x4*)(W + (size_t)(k0 + 8 * i + kq) * N + n0 + 4 * nq);
#pragma unroll
    for (int i = 0; i < 8; ++i) { const int kk = 8 * i + kq; const float gk = kgain ? kgain[k0 + kk] : 1.0f;
        LAS float* d = scr + kk * 33 + 4 * nq; d[0] = v[i][0] * gk; d[1] = v[i][1] * gk; d[2] = v[i][2] * gk; d[3] = v[i][3] * gk; }
    asm volatile("s_waitcnt lgkmcnt(0)" ::: "memory");
    const int c = lane & 7;
#pragma unroll
    for (int j = 0; j < 4; ++j) { const int n = (lane >> 3) + 8 * j; const LAS float* s = scr + (8 * c) * 33 + n;
        u32x4 o; o.x = pk2(s[0 * 33], s[1 * 33]); o.y = pk2(s[2 * 33], s[3 * 33]); o.z = pk2(s[4 * 33], s[5 * 33]); o.w = pk2(s[6 * 33], s[7 * 33]);
        const int ns = n0 + n; const int nd = half ? (ns < half ? 2 * ns : 2 * (ns - half) + 1) : ns;
        *(u32x4*)(WT + (size_t)nd * K + k0 + 8 * c) = o; }
    asm volatile("s_waitcnt lgkmcnt(0)" ::: "memory");
}

DI void phase0(PPtr p, ldsp lds, int tid, int wave, int lane) {
    LAS float* sc = (LAS float*)lds;
    LAS float* red = (LAS float*)(lds + 16384);
    LAS float* red2 = (LAS float*)(lds + 16384 + 32768);
    for (int i = tid; i < 4096; i += 512) { const float v = p->c[i]; sc[i] = v / (1.0f + __expf(-v)); }
    __syncthreads();
    float* mods = (float*)(p->ws + WS_MODS);
    const int cgp = tid & 7, ks = tid >> 3;
    for (int item = blockIdx.x; item < 1152; item += gridDim.x) {
        const int ge0 = item * 32, l = ge0 / 9216, e0 = ge0 % 9216;
        const float* W = p->ada_w + (size_t)l * 1024 * 9216 + e0 + 4 * cgp;
        f32x4 acc[4];
#pragma unroll
        for (int b = 0; b < 4; ++b) acc[b] = (f32x4){0.f, 0.f, 0.f, 0.f};
        f32x4 wv[16];
#pragma unroll
        for (int kk = 0; kk < 16; ++kk) wv[kk] = *(const f32x4*)(W + (size_t)(ks * 16 + kk) * 9216);
#pragma unroll
        for (int kk = 0; kk < 16; ++kk) { const int k = ks * 16 + kk;
#pragma unroll
            for (int b = 0; b < 4; ++b) acc[b] += wv[kk] * sc[b * 1024 + k]; }
#pragma unroll
        for (int b = 0; b < 4; ++b) *(LAS f32x4*)(red + ks * 128 + b * 32 + 4 * cgp) = acc[b];
        __syncthreads();
        { const int oc = tid & 127, part = tid >> 7; float s = 0.f;
#pragma unroll
          for (int j = 0; j < 16; ++j) s += red[(part * 16 + j) * 128 + oc];
          red2[part * 128 + oc] = s; }
        __syncthreads();
        if (tid < 128) { const float s = (red2[tid] + red2[128 + tid]) + (red2[256 + tid] + red2[384 + tid]);
            const int b = tid >> 5, col = tid & 31;
            mods[(size_t)(l * 4 + b) * 9216 + e0 + col] = s + p->ada_b[l * 9216 + e0 + col]; }
    }
    LAS float* scr = (LAS float*)(lds + 65536 + wave * 8448);
    const int gw = blockIdx.x * 8 + wave, ngw = gridDim.x * 8;
    constexpr int I_GU = 16 * 176, I_DN = 44 * 32, I_A = 16 * 21, I_QB = 6 * 48, I_KVB = 4 * 64, I_O = 16 * 32, I_IN = 16 * 161, I_OUT = 32 * 32;
    constexpr int NITEMS = 8 * I_GU + 8 * I_DN + 2 * (I_A + I_QB + I_KVB + I_O + I_IN + I_OUT);
    for (int it = gw; it < NITEMS; it += ngw) {
        int r = it; const float* src; bf16_t* dst; const float* kg = nullptr; int K, N, half = 0, li, m;
        if (r < 8 * I_GU) { m = r / I_GU; li = r % I_GU; K = 1024; N = 5632; half = 2816; src = p->ffn_w_gu + (size_t)m * 1024 * 5632; dst = (bf16_t*)(p->ws + WS_WGU + m * SZ_WGU); }
        else if ((r -= 8 * I_GU) < 8 * I_DN) { m = r / I_DN; li = r % I_DN; K = 2816; N = 1024; src = p->ffn_w_down + (size_t)m * 2816 * 1024; dst = (bf16_t*)(p->ws + WS_WDN + m * SZ_WDN); }
        else if ((r -= 8 * I_DN) < 2 * I_A) { m = r / I_A; li = r % I_A; K = 1024; N = ADIM; src = p->mla_w_a + (size_t)m * 1024 * ADIM; dst = (bf16_t*)(p->ws + WS_WA + m * SZ_WA); }
        else if ((r -= 2 * I_A) < 2 * I_QB) { m = r / I_QB; li = r % I_QB; K = 384; N = 1536; src = p->mla_w_qb + (size_t)m * 384 * 1536; dst = (bf16_t*)(p->ws + WS_WQB + m * SZ_WQB); kg = p->mla_q_a_gain + m * 384; }
        else if ((r -= 2 * I_QB) < 2 * I_KVB) { m = r / I_KVB; li = r % I_KVB; K = 256; N = 2048; src = p->mla_w_kvb + (size_t)m * 256 * 2048; dst = (bf16_t*)(p->ws + WS_WKVB + m * SZ_WKVB); kg = p->mla_kv_a_gain + m * 256; }
        else if ((r -= 2 * I_KVB) < 2 * I_O) { m = r / I_O; li = r % I_O; K = 1024; N = 1024; src = p->mla_w_o + (size_t)m * 1024 * 1024; dst = (bf16_t*)(p->ws + WS_WO + m * SZ_WO); }
        else if ((r -= 2 * I_O) < 2 * I_IN) { m = r / I_IN; li = r % I_IN; K = 1024; N = INP; src = p->ssd_w_in + (size_t)m * 1024 * INP; dst = (bf16_t*)(p->ws + WS_WIN + m * SZ_WIN); }
        else { r -= 2 * I_IN; m = r / I_OUT; li = r % I_OUT; K = 2048; N = 1024; src = p->ssd_w_out + (size_t)m * 2048 * 1024; dst = (bf16_t*)(p->ws + WS_WOUT + m * SZ_WOUT); kg = p->ssd_norm_gain + m * 2048; }
        cvt_item(src, K, N, dst, kg, half, scr, li, lane);
    }
    constexpr int PA = (ADIMP - ADIM) * 1024 * 2 / 16, PI = (INPP - INP) * 1024 * 2 / 16;
    const u32x4 z4 = {0u, 0u, 0u, 0u};
    for (int i = blockIdx.x * 512 + tid; i < 2 * (PA + PI); i += gridDim.x * 512) {
        int r = i; unsigned char* d;
        if (r < 2 * PA) { const int m = r / PA; d = p->ws + WS_WA + m * SZ_WA + (size_t)ADIM * 1024 * 2 + (size_t)(r % PA) * 16; }
        else { r -= 2 * PA; const int m = r / PI; d = p->ws + WS_WIN + m * SZ_WIN + (size_t)INP * 1024 * 2 + (size_t)(r % PI) * 16; }
        *(u32x4*)d = z4;
    }
}

DI void norm_phase(const float* xin, const float* gain, const float* mods_ls, bf16_t* h, int wave, int lane) {
    const int vb = (gridDim.x == 256) ? ((blockIdx.x & 7) * 32 + (blockIdx.x >> 3)) : (int)blockIdx.x;
    const int gw = vb * 8 + wave, ngw = gridDim.x * 8;
    for (int blk = gw; blk < T / 8; blk += ngw) {
        const int m0 = blk * 8, b = m0 >> 12;
        const float* shift = mods_ls + (size_t)b * 9216; const float* scale = shift + 1024;
        f32x4 gsc[4], sh[4];
#pragma unroll
        for (int j = 0; j < 4; ++j) { const int c = 4 * lane + 256 * j; gsc[j] = *(const f32x4*)(gain + c) * (*(const f32x4*)(scale + c) + 1.0f); sh[j] = *(const f32x4*)(shift + c); }
#pragma unroll 2
        for (int r = 0; r < 8; ++r) {
            const float* xr = xin + (size_t)(m0 + r) * DM + 4 * lane;
            f32x4 v[4]; float ss = 0.f;
#pragma unroll
            for (int j = 0; j < 4; ++j) { v[j] = *(const f32x4*)(xr + 256 * j); ss += (v[j].x * v[j].x + v[j].y * v[j].y) + (v[j].z * v[j].z + v[j].w * v[j].w); }
            const float rstd = rsqrtf(wave_sum(ss) * (1.0f / DM) + EPS);
            bf16_t* hr = h + (size_t)(m0 + r) * DM + 4 * lane;
#pragma unroll
            for (int j = 0; j < 4; ++j) { const f32x4 o = v[j] * rstd * gsc[j] + sh[j]; u32x2 w; w.x = pk2(o.x, o.y); w.y = pk2(o.z, o.w); *(u32x2*)(hr + 256 * j) = w; }
        }
    }
}

DI void mla_finalize(PPtr p, int j, ldsp lds, int tid, int wave, int lane) {
    const bf16_t* aout = (const bf16_t*)(p->ws + WS_AOUT); const bf16_t* qraw = (const bf16_t*)(p->ws + WS_QRAW); const bf16_t* kvraw = (const bf16_t*)(p->ws + WS_KVRAW);
    bf16_t* Qb = (bf16_t*)(p->ws + WS_QB); bf16_t* Kb = (bf16_t*)(p->ws + WS_KB); bf16_t* Vt = (bf16_t*)(p->ws + WS_VT);
    const float* qg = p->mla_q_gain + j * QKH; const float* kg = p->mla_k_gain + j * QKH;
    constexpr int VTP = 40;
    const int head = lane >> 2, sub = lane & 3;
    for (int item = blockIdx.x; item < T / 32; item += gridDim.x) {
        const int t0 = item * 32, b = t0 >> 12, s0 = t0 & 4095;
        for (int rr = 0; rr < 4; ++rr) {
            const int tok = wave * 4 + rr, t = t0 + tok;
            float ssq = 0.f, sskv = 0.f;
            if (lane < 48) { const u32x4 w = *(const u32x4*)(aout + (size_t)t * ADIMP + 8 * lane);
#pragma unroll
                for (int i = 0; i < 4; ++i) { const float a = bflo(w[i]), c = bfhi(w[i]); ssq += a * a + c * c; } }
            if (lane < 32) { const u32x4 w = *(const u32x4*)(aout + (size_t)t * ADIMP + QL + 8 * lane);
#pragma unroll
                for (int i = 0; i < 4; ++i) { const float a = bflo(w[i]), c = bfhi(w[i]); sskv += a * a + c * c; } }
            const float rq = rsqrtf(wave_sum(ssq) * (1.0f / QL) + EPS), rkv = rsqrtf(wave_sum(sskv) * (1.0f / KVL) + EPS);
            float cs, sn;
            { const int fi = lane & 15; const float inv = exp2f(-(float)fi * (13.287712379549449f / 16.0f));
              const float ang = (float)p->pos[t] * inv; double rev = (double)ang * 0.15915494309189535; rev -= floor(rev); const float rv = (float)rev;
              cs = __builtin_amdgcn_cosf(rv); sn = __builtin_amdgcn_sinf(rv); }
            float cj[8], sj[8];
#pragma unroll
            for (int i = 0; i < 8; ++i) { cj[i] = __shfl(cs, 8 * (sub & 1) + i); sj[i] = __shfl(sn, 8 * (sub & 1) + i); }
#pragma unroll
            for (int which = 0; which < 2; ++which) {
                float v[24];
                if (which == 0) {
                    const bf16_t* src = qraw + (size_t)t * 1536 + head * QKH;
#pragma unroll
                    for (int g = 0; g < 3; ++g) { const u32x4 w = *(const u32x4*)(src + 8 * (sub + 4 * g));
#pragma unroll
                        for (int i = 0; i < 4; ++i) { v[8 * g + 2 * i] = bflo(w[i]) * rq; v[8 * g + 2 * i + 1] = bfhi(w[i]) * rq; } }
                } else {
                    const bf16_t* src = kvraw + (size_t)t * 2048 + head * 128;
#pragma unroll
                    for (int g = 0; g < 2; ++g) { const u32x4 w = *(const u32x4*)(src + 8 * (sub + 4 * g));
#pragma unroll
                        for (int i = 0; i < 4; ++i) { v[8 * g + 2 * i] = bflo(w[i]) * rkv; v[8 * g + 2 * i + 1] = bfhi(w[i]) * rkv; } }
                    const u32x4 w = *(const u32x4*)(aout + (size_t)t * ADIMP + QL + KVL + 8 * sub);
#pragma unroll
                    for (int i = 0; i < 4; ++i) { v[16 + 2 * i] = bflo(w[i]); v[16 + 2 * i + 1] = bfhi(w[i]); }
                }
                float ss = 0.f;
#pragma unroll
                for (int i = 0; i < 24; ++i) ss += v[i] * v[i];
                ss += __shfl_xor(ss, 1); ss += __shfl_xor(ss, 2);
                const float rs = rsqrtf(ss * (1.0f / QKH) + EPS);
                const float* gn = which == 0 ? qg : kg;
#pragma unroll
                for (int g = 0; g < 3; ++g) { const f32x4 g0 = *(const f32x4*)(gn + 8 * (sub + 4 * g)), g1 = *(const f32x4*)(gn + 8 * (sub + 4 * g) + 4);
#pragma unroll
                    for (int i = 0; i < 4; ++i) { v[8 * g + i] *= rs * g0[i]; v[8 * g + 4 + i] *= rs * g1[i]; } }
#pragma unroll
                for (int i = 0; i < 8; ++i) { const float mine = v[16 + i], other = __shfl_xor(mine, 2);
                    v[16 + i] = (sub < 2) ? (mine * cj[i] - other * sj[i]) : (other * sj[i] + mine * cj[i]); }
                const float osc = which == 0 ? QSCALE : 1.0f;
                bf16_t* dst = (which == 0 ? Qb : Kb) + ((size_t)t * HEADS + head) * QKH;
#pragma unroll
                for (int g = 0; g < 3; ++g) { u32x4 w;
#pragma unroll
                    for (int i = 0; i < 4; ++i) w[i] = pk2(v[8 * g + 2 * i] * osc, v[8 * g + 2 * i + 1] * osc);
                    *(u32x4*)(dst + 8 * (sub + 4 * g)) = w; }
            }
            { const bf16_t* src = kvraw + (size_t)t * 2048 + head * 128 + 64 + 16 * sub;
#pragma unroll
              for (int g = 0; g < 2; ++g) { const u32x4 w = *(const u32x4*)(src + 8 * g);
#pragma unroll
                  for (int i = 0; i < 4; ++i) { const int d = head * 64 + 16 * sub + 8 * g + 2 * i;
                      *(LAS bf16_t*)(lds + ((d) * VTP + tok) * 2) = f2bf(bflo(w[i]) * rkv);
                      *(LAS bf16_t*)(lds + ((d + 1) * VTP + tok) * 2) = f2bf(bfhi(w[i]) * rkv); } } }
        }
        __syncthreads();
#pragma unroll
        for (int k = 0; k < 8; ++k) { const int id = tid + 512 * k, row = id >> 2, ch = id & 3;
            const u32x4 w = *(const LAS u32x4*)(lds + (row * VTP + ch * 8) * 2);
            *(u32x4*)(Vt + ((size_t)b * 1024 + row) * SEQ + s0 + ch * 8) = w; }
        __syncthreads();
    }
}

DI void attn_phase(PPtr p, int j, ldsp lds, int tid, int wave, int lane) {
    const bf16_t* Qb = (const bf16_t*)(p->ws + WS_QB); const bf16_t* Kb = (const bf16_t*)(p->ws + WS_KB); const bf16_t* Vt = (const bf16_t*)(p->ws + WS_VT);
    bf16_t* O = (bf16_t*)(p->ws + WS_O);
    constexpr int KP = 104, VP = 68, KBYTES = 64 * KP * 2, VBYTES = 64 * VP * 2, BUF = KBYTES + VBYTES;
    const int r = lane & 31, hi = lane >> 5;
    const int k1row = tid / 12, k1ch = tid % 12, k2row = (tid + 512) / 12, k2ch = (tid + 512) % 12, vrow = tid >> 3, vch = tid & 7;
    float mfix;
    { float gq = fabsf(p->mla_q_gain[j * QKH + lane]), gk = fabsf(p->mla_k_gain[j * QKH + lane]);
      if (lane < 32) { gq = fmaxf(gq, fabsf(p->mla_q_gain[j * QKH + 64 + lane])); gk = fmaxf(gk, fabsf(p->mla_k_gain[j * QKH + 64 + lane])); }
#pragma unroll
      for (int o = 1; o < 64; o <<= 1) { gq = fmaxf(gq, __shfl_xor(gq, o)); gk = fmaxf(gk, __shfl_xor(gk, o)); }
      mfix = QSCALE * 96.0f * gq * gk; }
    for (int item = blockIdx.x; item < 512; item += gridDim.x) {
        const int bh = item >> 3, jj = item & 7, b = bh >> 4, hd = bh & 15;
        const bf16_t* kbase = Kb + ((size_t)b * SEQ * HEADS + hd) * QKH;
        const bf16_t* vbase = Vt + ((size_t)(b * HEADS + hd) * 64) * SEQ;
        for (int half = 0; half < 2; ++half) {
            const int qb = half ? 15 - jj : jj, q0 = qb * 256, nt = 4 * qb + 4;
            const int qrow = q0 + 32 * wave + r;
            bf16x8 qf[6];
            { const bf16_t* qp = Qb + ((size_t)(b * SEQ + qrow) * HEADS + hd) * QKH + 8 * hi;
#pragma unroll
              for (int ks = 0; ks < 6; ++ks) qf[ks] = *(const bf16x8*)(qp + 16 * ks); }
            f32x16 o0, o1;
#pragma unroll
            for (int i = 0; i < 16; ++i) { o0[i] = 0.f; o1[i] = 0.f; }
            float lrun = 0.f;
            u32x4 kr1, kr2 = {0u, 0u, 0u, 0u}, vr;
#define ATT_LOAD(kt) do { kr1 = *(const u32x4*)(kbase + (size_t)(64 * (kt) + k1row) * (HEADS * QKH) + k1ch * 8); \
                if (tid < 256) kr2 = *(const u32x4*)(kbase + (size_t)(64 * (kt) + k2row) * (HEADS * QKH) + k2ch * 8); \
                vr = *(const u32x4*)(vbase + (size_t)vrow * SEQ + 64 * (kt) + vch * 8); } while (0)
#define ATT_STORE(bf) do { *(LAS u32x4*)(lds + (bf) * BUF + (k1row * KP + k1ch * 8) * 2) = kr1; \
                if (tid < 256) *(LAS u32x4*)(lds + (bf) * BUF + (k2row * KP + k2ch * 8) * 2) = kr2; \
                *(LAS u32x2*)(lds + (bf) * BUF + KBYTES + (vrow * VP + vch * 8) * 2) = (u32x2){vr[0], vr[1]}; \
                *(LAS u32x2*)(lds + (bf) * BUF + KBYTES + (vrow * VP + vch * 8) * 2 + 8) = (u32x2){vr[2], vr[3]}; } while (0)
            ATT_LOAD(0); ATT_STORE(0);
            __syncthreads();
            for (int kt = 0; kt < nt; ++kt) {
                const int buf = kt & 1;
                if (kt + 1 < nt) ATT_LOAD(kt + 1);
                const int k0 = 64 * kt;
                if (k0 <= q0 + 32 * wave + 31) {
                    f32x16 s0, s1;
#pragma unroll
                    for (int i = 0; i < 16; ++i) { s0[i] = -mfix; s1[i] = -mfix; }
                    const ldsp kb0 = lds + buf * BUF + (r * KP + 8 * hi) * 2;
                    bf16x8 ka[6], kc[6];
#pragma unroll
                    for (int ks = 0; ks < 6; ++ks) { ka[ks] = *(const LAS bf16x8*)(kb0 + ks * 32); kc[ks] = *(const LAS bf16x8*)(kb0 + 32 * KP * 2 + ks * 32); }
                    __builtin_amdgcn_sched_barrier(0);
#pragma unroll
                    for (int ks = 0; ks < 6; ++ks) s0 = MFMA32(ka[ks], qf[ks], s0);
#pragma unroll
                    for (int ks = 0; ks < 6; ++ks) s1 = MFMA32(kc[ks], qf[ks], s1);
                    const ldsp vb0 = lds + buf * BUF + KBYTES + (r * VP + 4 * hi) * 2;
                    s16x4 vlo0[4], vhi0[4], vlo1[4], vhi1[4];
#pragma unroll
                    for (int q = 0; q < 4; ++q) { const ldsp va = vb0 + (16 * q) * 2;
                        vlo0[q] = *(const LAS s16x4*)(va); vhi0[q] = *(const LAS s16x4*)(va + 16);
                        vlo1[q] = *(const LAS s16x4*)(va + 32 * VP * 2); vhi1[q] = *(const LAS s16x4*)(va + 32 * VP * 2 + 16); }
                    const bool diag = (k0 + 63 > q0 + 32 * wave);
                    float psum = 0.f;
                    if (diag) {
#pragma unroll
                        for (int i = 0; i < 16; ++i) { const int key = k0 + crow(i, hi); if (key > qrow) s0[i] = -INFINITY; }
                    }
#pragma unroll
                    for (int i = 0; i < 16; ++i) { s0[i] = __builtin_amdgcn_exp2f(s0[i]); psum += s0[i]; }
#pragma unroll
                    for (int q = 0; q < 2; ++q) { const bf16x8 pf = pack8(s0, q);
                        const bf16x8 vf0 = __builtin_shufflevector(vlo0[q], vhi0[q], 0, 1, 2, 3, 4, 5, 6, 7), vf1 = __builtin_shufflevector(vlo1[q], vhi1[q], 0, 1, 2, 3, 4, 5, 6, 7);
                        o0 = MFMA32(vf0, pf, o0); o1 = MFMA32(vf1, pf, o1); }
                    if (diag) {
#pragma unroll
                        for (int i = 0; i < 16; ++i) { const int key = k0 + 32 + crow(i, hi); if (key > qrow) s1[i] = -INFINITY; }
                    }
#pragma unroll
                    for (int i = 0; i < 16; ++i) { s1[i] = __builtin_amdgcn_exp2f(s1[i]); psum += s1[i]; }
                    lrun += psum;
#pragma unroll
                    for (int q = 2; q < 4; ++q) { const bf16x8 pf = pack8(s1, q & 1);
                        const bf16x8 vf0 = __builtin_shufflevector(vlo0[q], vhi0[q], 0, 1, 2, 3, 4, 5, 6, 7), vf1 = __builtin_shufflevector(vlo1[q], vhi1[q], 0, 1, 2, 3, 4, 5, 6, 7);
                        o0 = MFMA32(vf0, pf, o0); o1 = MFMA32(vf1, pf, o1); }
                }
                if (kt + 1 < nt) ATT_STORE(buf ^ 1);
                __syncthreads();
            }
#undef ATT_LOAD
#undef ATT_STORE
            const float inv = 1.0f / (lrun + __shfl_xor(lrun, 32));
            bf16_t* op = O + (size_t)(b * SEQ + qrow) * DM + hd * 64 + 4 * hi;
#pragma unroll
            for (int g = 0; g < 4; ++g) {
                u32x2 w0, w1; w0.x = pk2(o0[4 * g] * inv, o0[4 * g + 1] * inv); w0.y = pk2(o0[4 * g + 2] * inv, o0[4 * g + 3] * inv);
                w1.x = pk2(o1[4 * g] * inv, o1[4 * g + 1] * inv); w1.y = pk2(o1[4 * g + 2] * inv, o1[4 * g + 3] * inv);
                *(u32x2*)(op + 8 * g) = w0; *(u32x2*)(op + 32 + 8 * g) = w1; }
        }
    }
}

DI void conv_phase(PPtr p, int j, ldsp lds, int tid) {
    const bf16_t* zx = (const bf16_t*)(p->ws + WS_ZX);
    bf16_t* xT = (bf16_t*)(p->ws + WS_XT); bf16_t* Bc = (bf16_t*)(p->ws + WS_BC); bf16_t* Cc = (bf16_t*)(p->ws + WS_CC); bf16_t* BT = (bf16_t*)(p->ws + WS_BT);
    const float* cw = p->ssd_conv_w + (size_t)j * 4 * CONVD; const float* cbias = p->ssd_conv_b + (size_t)j * CONVD;
    constexpr int TPB = 140;
    {
        const int lane = tid & 63, wave = tid >> 6, r = lane & 31, hi = lane >> 5, kq = wave & 3;
        const bf16_t* hb = (const bf16_t*)(p->ws + WS_H); const bf16_t* wdt = (const bf16_t*)(p->ws + WS_WIN + (size_t)j * SZ_WIN) + (size_t)ZXW * DM;
        float* dtraw = (float*)(p->ws + WS_DTRAW);
        for (int base = blockIdx.x * 2; base < T / 32; base += gridDim.x * 2) {
            const int rt = base + (wave >> 2);
            const bf16_t* ap = hb + (size_t)(rt * 32 + r) * DM + kq * 256 + 8 * hi; const bf16_t* bp = wdt + (size_t)r * DM + kq * 256 + 8 * hi;
            f32x16 d0, d1;
#pragma unroll
            for (int i = 0; i < 16; ++i) { d0[i] = 0.f; d1[i] = 0.f; }
            bf16x8 fa[16], fb[16];
#pragma unroll
            for (int ks = 0; ks < 16; ++ks) { fa[ks] = *(const bf16x8*)(ap + ks * 16); fb[ks] = *(const bf16x8*)(bp + ks * 16); }
#pragma unroll
            for (int ks = 0; ks < 16; ks += 2) { d0 = MFMA32(fa[ks], fb[ks], d0); d1 = MFMA32(fa[ks + 1], fb[ks + 1], d1); }
#pragma unroll
            for (int i = 0; i < 16; ++i) *(LAS float*)(lds + ((wave * 16 + i) * 64 + lane) * 4) = d0[i] + d1[i];
            __syncthreads();
            if (kq == 0) {
                float* op = dtraw + (size_t)(rt * 32) * 32 + r;
#pragma unroll
                for (int i = 0; i < 16; ++i) { float v = 0.f;
#pragma unroll
                    for (int q = 0; q < 4; ++q) v += *(const LAS float*)(lds + (((wave + q) * 16 + i) * 64 + lane) * 4);
                    op[(size_t)crow(i, hi) * 32] = v; }
            }
            __syncthreads();
        }
    }
    const int tok = tid >> 3, cgp = tid & 7;
    for (int item = blockIdx.x; item < 256 * 12; item += gridDim.x) {
        const int tt = item / 12, cb = item % 12;
        const int t0 = tt * 64, b = t0 >> 12, s0 = t0 & 4095;
        const int t = t0 + tok, s = s0 + tok;
        u32x4 u[4][4];
#pragma unroll
        for (int k = 0; k < 4; ++k)
#pragma unroll
            for (int w = 0; w < 4; ++w) {
                const int ch0 = cb * 256 + (cgp + 8 * k) * 8;
                if (s - 3 + w >= 0) u[k][w] = *(const u32x4*)(zx + (size_t)(t - 3 + w) * ZXW + DIN + ch0);
                else u[k][w] = (u32x4){0u, 0u, 0u, 0u};
            }
#pragma unroll
        for (int k = 0; k < 4; ++k) {
            const int cl = (cgp + 8 * k) * 8, ch0 = cb * 256 + cl;
            float acc[8];
            { const f32x4 b0 = *(const f32x4*)(cbias + ch0), b1 = *(const f32x4*)(cbias + ch0 + 4);
#pragma unroll
              for (int i = 0; i < 4; ++i) { acc[i] = b0[i]; acc[4 + i] = b1[i]; } }
#pragma unroll
            for (int w = 0; w < 4; ++w) {
                const f32x4 w0 = *(const f32x4*)(cw + w * CONVD + ch0), w1 = *(const f32x4*)(cw + w * CONVD + ch0 + 4);
                const u32x4 uu = u[k][w];
                acc[0] += bflo(uu[0]) * w0[0]; acc[1] += bfhi(uu[0]) * w0[1]; acc[2] += bflo(uu[1]) * w0[2]; acc[3] += bfhi(uu[1]) * w0[3];
                acc[4] += bflo(uu[2]) * w1[0]; acc[5] += bfhi(uu[2]) * w1[1]; acc[6] += bflo(uu[3]) * w1[2]; acc[7] += bfhi(uu[3]) * w1[3];
            }
#pragma unroll
            for (int i = 0; i < 8; ++i) acc[i] = silu_f(acc[i]);
            if (cb >= 8) { u32x4 w; w.x = pk2(acc[0], acc[1]); w.y = pk2(acc[2], acc[3]); w.z = pk2(acc[4], acc[5]); w.w = pk2(acc[6], acc[7]);
                bf16_t* dst = (cb < 10) ? Bc + (size_t)t * 512 + (cb - 8) * 256 + cl : Cc + (size_t)t * 512 + (cb - 10) * 256 + cl;
                *(u32x4*)dst = w; }
            if (cb < 10) {
#pragma unroll
                for (int i = 0; i < 8; ++i) *(LAS bf16_t*)(lds + (cl + i) * TPB + tok * 2) = f2bf(acc[i]);
            }
        }
        if (cb < 10) {
            __syncthreads();
#pragma unroll
            for (int k = 0; k < 4; ++k) { const int id = tid + 512 * k, row = id >> 3, ch = id & 7;
                const ldsp src = lds + row * TPB + ch * 16;
                u32x4 w; w.x = *(const LAS unsigned*)(src); w.y = *(const LAS unsigned*)(src + 4); w.z = *(const LAS unsigned*)(src + 8); w.w = *(const LAS unsigned*)(src + 12);
                bf16_t* dst = (cb < 8) ? xT + ((size_t)b * 2048 + cb * 256 + row) * SEQ + s0 + ch * 8 : BT + ((size_t)b * 512 + (cb - 8) * 256 + row) * SEQ + s0 + ch * 8;
                *(u32x4*)dst = w; }
            __syncthreads();
        }
    }
}

DI void scan_phase(PPtr p, int j, ldsp lds, int tid, int wave, int lane) {
    const bf16_t* xT = (const bf16_t*)(p->ws + WS_XT); const bf16_t* Bc = (const bf16_t*)(p->ws + WS_BC); const bf16_t* Cc = (const bf16_t*)(p->ws + WS_CC);
    const bf16_t* BT = (const bf16_t*)(p->ws + WS_BT); const float* dtraw = (const float*)(p->ws + WS_DTRAW); bf16_t* Y = (bf16_t*)(p->ws + WS_Y);
    constexpr int PT = 136, PB = PT * 2;
    constexpr int O_C = 0, O_B = 128 * PB, O_BT = 2 * 128 * PB, O_X = 3 * 128 * PB, O_XW = O_X + 32 * PB, O_S = O_XW + 32 * PB, O_DT = O_S + 32 * PB, O_AC = O_DT + 8 * 512;
    LAS float* s_dt = (LAS float*)(lds + O_DT + wave * 512); LAS float* s_ac = (LAS float*)(lds + O_AC + wave * 512);
    const int r = lane & 31, hi = lane >> 5;
    for (int unit0 = blockIdx.x; unit0 < 256; unit0 += gridDim.x) {
        const int unit = (gridDim.x == 256) ? ((unit0 & 7) * 32 + (unit0 >> 3)) : unit0;
        const int b = unit >> 6, h = (unit >> 1) & 31, ph = unit & 1, g = h >> 3;
        const float A = -__expf(p->ssd_a_log[j * SSDH + h]); const float dtb = p->ssd_dt_bias[j * SSDH + h]; const float Dh = p->ssd_d[j * SSDH + h];
        f32x16 accS;
#pragma unroll
        for (int i = 0; i < 16; ++i) accS[i] = 0.f;
        for (int i = tid; i < 32 * PB / 4; i += 512) *(LAS unsigned*)(lds + O_S + i * 4) = 0u;
        u32x4 rc[4], rb[4], rbt[4], rx; float dr0, dr1;
        const unsigned offRow = (unsigned)((tid >> 4) * 512 + (tid & 15) * 8), offT = (unsigned)((tid >> 4) * SEQ + (tid & 15) * 8);
        const bf16_t* cBase = Cc + (size_t)b * SEQ * 512 + g * 128; const bf16_t* bBase = Bc + (size_t)b * SEQ * 512 + g * 128;
        const bf16_t* btBase = BT + ((size_t)b * 512 + g * 128) * SEQ; const bf16_t* xBase = xT + ((size_t)b * 2048 + h * 64 + ph * 32) * SEQ;
        const float* dBase = dtraw + (size_t)b * SEQ * 32 + h;
#define SCAN_LOAD(c) do { const bf16_t* c_ = cBase + (size_t)(c) * 128 * 512; const bf16_t* b_ = bBase + (size_t)(c) * 128 * 512; const bf16_t* bt_ = btBase + (c) * 128; \
            _Pragma("unroll") for (int k = 0; k < 4; ++k) { \
                rc[k] = *(const u32x4*)(c_ + (offRow + (unsigned)(k * 32 * 512))); \
                rb[k] = *(const u32x4*)(b_ + (offRow + (unsigned)(k * 32 * 512))); \
                rbt[k] = *(const u32x4*)(bt_ + (offT + (unsigned)(k * 32 * SEQ))); } \
            rx = *(const u32x4*)(xBase + (c) * 128 + offT); \
            dr0 = dBase[(unsigned)(((c) * 128 + lane) * 32)]; dr1 = dBase[(unsigned)(((c) * 128 + lane + 64) * 32)]; } while (0)
        SCAN_LOAD(0);
        for (int c = 0; c < 32; ++c) {
            const int t0 = b * SEQ + c * 128;
            {
                const float x0 = dr0 + dtb, x1 = dr1 + dtb;
                const float d0 = x0 > 20.f ? x0 : log1pf(__expf(x0)), d1 = x1 > 20.f ? x1 : log1pf(__expf(x1));
                float v0 = d0 * A * 1.4426950408889634f, v1 = d1 * A * 1.4426950408889634f;
#pragma unroll
                for (int off = 1; off < 64; off <<= 1) { const float n0 = __shfl_up(v0, off), n1 = __shfl_up(v1, off); if (lane >= off) { v0 += n0; v1 += n1; } }
                v1 += __shfl(v0, 63);
                s_dt[lane] = d0; s_dt[lane + 64] = d1; s_ac[lane] = v0; s_ac[lane + 64] = v1;
            }
#pragma unroll
            for (int k = 0; k < 4; ++k) { const int id = tid + 512 * k, row = id >> 4, ch = id & 15; const int off = (row * PT + ch * 8) * 2;
                *(LAS u32x4*)(lds + O_C + off) = rc[k]; *(LAS u32x4*)(lds + O_B + off) = rb[k]; *(LAS u32x4*)(lds + O_BT + off) = rbt[k]; }
            { const int row = tid >> 4, ch = tid & 15; const int off = (row * PT + ch * 8) * 2;
              const float aend = s_ac[127]; u32x4 w, wd;
              const f32x4 da = *(const LAS f32x4*)(s_dt + ch * 8), db = *(const LAS f32x4*)(s_dt + ch * 8 + 4), aa = *(const LAS f32x4*)(s_ac + ch * 8), ab = *(const LAS f32x4*)(s_ac + ch * 8 + 4);
              float xd[8];
              xd[0] = bflo(rx[0]) * da[0]; xd[1] = bfhi(rx[0]) * da[1]; xd[2] = bflo(rx[1]) * da[2]; xd[3] = bfhi(rx[1]) * da[3];
              xd[4] = bflo(rx[2]) * db[0]; xd[5] = bfhi(rx[2]) * db[1]; xd[6] = bflo(rx[3]) * db[2]; xd[7] = bfhi(rx[3]) * db[3];
              wd[0] = pk2(xd[0], xd[1]); wd[1] = pk2(xd[2], xd[3]); wd[2] = pk2(xd[4], xd[5]); wd[3] = pk2(xd[6], xd[7]);
              w[0] = pk2(xd[0] * __builtin_amdgcn_exp2f(aend - aa[0]), xd[1] * __builtin_amdgcn_exp2f(aend - aa[1]));
              w[1] = pk2(xd[2] * __builtin_amdgcn_exp2f(aend - aa[2]), xd[3] * __builtin_amdgcn_exp2f(aend - aa[3]));
              w[2] = pk2(xd[4] * __builtin_amdgcn_exp2f(aend - ab[0]), xd[5] * __builtin_amdgcn_exp2f(aend - ab[1]));
              w[3] = pk2(xd[6] * __builtin_amdgcn_exp2f(aend - ab[2]), xd[7] * __builtin_amdgcn_exp2f(aend - ab[3]));
              *(LAS u32x4*)(lds + O_X + off) = wd;
              *(LAS u32x4*)(lds + O_XW + off) = w; }
            if (c + 1 < 32) SCAN_LOAD(c + 1);
            LDS_BARRIER();
#define SCAN_BLOCK(YACC, sb, DIAG) do { \
                    f32x16 cb; \
                    _Pragma("unroll") for (int i = 0; i < 16; ++i) cb[i] = 0.f; \
                    _Pragma("unroll") for (int kh = 0; kh < 2; ++kh) { \
                        _Pragma("unroll") for (int ks = 0; ks < 4; ++ks) { fa[ks] = *(const LAS bf16x8*)(lds + O_B + ((32 * (sb) + r) * PT + 16 * (4 * kh + ks) + 8 * hi) * 2); \
                            fc[ks] = *(const LAS bf16x8*)(lds + O_C + (l * PT + 16 * (4 * kh + ks) + 8 * hi) * 2); } \
                        __builtin_amdgcn_sched_barrier(0); \
                        _Pragma("unroll") for (int ks = 0; ks < 4; ++ks) cb = MFMA32(fa[ks], fc[ks], cb); \
                    } \
                    _Pragma("unroll") for (int gq = 0; gq < 4; ++gq) { \
                        const int sbase = 32 * (sb) + 8 * gq + 4 * hi; \
                        const f32x4 acs = *(const LAS f32x4*)(s_ac + sbase); \
                        _Pragma("unroll") for (int q = 0; q < 4; ++q) { \
                            float v = cb[4 * gq + q] * __builtin_amdgcn_exp2f(acl - acs[q]); \
                            if (DIAG) { const int sidx = sbase + q; v = (sidx <= l) ? v : 0.f; if (sidx == l) v += dskip; } \
                            cb[4 * gq + q] = v; } \
                    } \
                    _Pragma("unroll") for (int ks2 = 0; ks2 < 2; ++ks2) { \
                        const bf16x8 pf = pack8(cb, ks2); \
                        const ldsp xa = lds + O_X + (r * PT + 32 * (sb) + 16 * ks2 + 4 * hi) * 2; \
                        const s16x4 lo = *(const LAS s16x4*)(xa), hh = *(const LAS s16x4*)(xa + 16); \
                        const bf16x8 xf = __builtin_shufflevector(lo, hh, 0, 1, 2, 3, 4, 5, 6, 7); \
                        YACC = MFMA32(xf, pf, YACC); } \
                } while (0)
            constexpr int O_PART = O_AC + 8 * 512;
            f32x16 ya;
#pragma unroll
            for (int i = 0; i < 16; ++i) ya[i] = 0.f;
            if (wave < 4) {
                const int lb = wave, l = 32 * lb + r; const float acl = s_ac[l];
                bf16x8 fa[4], fc[4];
#pragma unroll
                for (int kh = 0; kh < 2; ++kh) {
#pragma unroll
                    for (int ks = 0; ks < 4; ++ks) { fa[ks] = *(const LAS bf16x8*)(lds + O_S + (r * PT + 16 * (4 * kh + ks) + 8 * hi) * 2);
                        fc[ks] = *(const LAS bf16x8*)(lds + O_C + (l * PT + 16 * (4 * kh + ks) + 8 * hi) * 2); }
                    __builtin_amdgcn_sched_barrier(0);
#pragma unroll
                    for (int ks = 0; ks < 4; ++ks) ya = MFMA32(fa[ks], fc[ks], ya);
                }
                { const float e = __builtin_amdgcn_exp2f(acl);
#pragma unroll
                  for (int i = 0; i < 16; ++i) ya[i] *= e; }
                const float dskip = Dh * __builtin_amdgcn_rcpf(s_dt[l]);
                if (lb >= 1) SCAN_BLOCK(ya, lb - 1, false);
                SCAN_BLOCK(ya, lb, true);
            } else {
                const int nb = wave - 4; const float dec = __builtin_amdgcn_exp2f(s_ac[127]);
                {
#pragma unroll
                    for (int i = 0; i < 16; ++i) accS[i] *= dec;
#pragma unroll
                    for (int kh = 0; kh < 2; ++kh) {
                        bf16x8 fa[4], fb[4];
#pragma unroll
                        for (int ks = 0; ks < 4; ++ks) { fa[ks] = *(const LAS bf16x8*)(lds + O_XW + (r * PT + 16 * (4 * kh + ks) + 8 * hi) * 2);
                            fb[ks] = *(const LAS bf16x8*)(lds + O_BT + ((32 * nb + r) * PT + 16 * (4 * kh + ks) + 8 * hi) * 2); }
                        __builtin_amdgcn_sched_barrier(0);
#pragma unroll
                        for (int ks = 0; ks < 4; ++ks) accS = MFMA32(fa[ks], fb[ks], accS);
                    }
                }
                if (nb >= 2) {
                    const int l = 32 * nb + r; const float acl = s_ac[l]; const float dskip = 0.f; (void)dskip;
                    bf16x8 fa[4], fc[4];
                    for (int sb = 0; sb <= nb - 2; ++sb) SCAN_BLOCK(ya, sb, false);
#pragma unroll
                    for (int i = 0; i < 16; ++i) *(LAS float*)(lds + O_PART + (((nb - 2) * 16 + i) * 64 + lane) * 4) = ya[i];
                }
            }
#undef SCAN_BLOCK
            LDS_BARRIER();
            if (wave < 4) {
                const int lb = wave, l = 32 * lb + r;
                if (lb >= 2) {
#pragma unroll
                    for (int i = 0; i < 16; ++i) ya[i] += *(const LAS float*)(lds + O_PART + (((lb - 2) * 16 + i) * 64 + lane) * 4);
                }
                bf16_t* yp = Y + (size_t)(t0 + l) * DIN + h * 64 + ph * 32 + 4 * hi;
#pragma unroll
                for (int gq = 0; gq < 4; ++gq) { u32x2 w; w.x = pk2(ya[4 * gq], ya[4 * gq + 1]); w.y = pk2(ya[4 * gq + 2], ya[4 * gq + 3]); *(u32x2*)(yp + 8 * gq) = w; }
            } else { const int nb = wave - 4;
#pragma unroll
                for (int i = 0; i < 16; ++i) *(LAS bf16_t*)(lds + O_S + (crow(i, hi) * PT + 32 * nb + r) * 2) = f2bf(accS[i]); }
        }
#undef SCAN_LOAD
        __syncthreads();
    }
}

DI void gatenorm_phase(PPtr p, int wave, int lane) {
    const bf16_t* zx = (const bf16_t*)(p->ws + WS_ZX); const bf16_t* Y = (const bf16_t*)(p->ws + WS_Y); bf16_t* gn = (bf16_t*)(p->ws + WS_GN);
    const int gw = blockIdx.x * 8 + wave, ngw = gridDim.x * 8;
    for (int t0 = gw * 2; t0 < T; t0 += ngw * 2) {
        u32x4 yv[2][4], zv[2][4];
#pragma unroll
        for (int rr = 0; rr < 2; ++rr)
#pragma unroll
            for (int jg = 0; jg < 4; ++jg) { const int c = 8 * (lane + 64 * jg);
                yv[rr][jg] = *(const u32x4*)(Y + (size_t)(t0 + rr) * DIN + c); zv[rr][jg] = *(const u32x4*)(zx + (size_t)(t0 + rr) * ZXW + c); }
#pragma unroll
        for (int rr = 0; rr < 2; ++rr)
#pragma unroll
            for (int jg = 0; jg < 4; ++jg) {
                const int c = 8 * (lane + 64 * jg);
                float v[8]; float ss = 0.f;
#pragma unroll
                for (int i = 0; i < 4; ++i) { v[2 * i] = bflo(yv[rr][jg][i]) * silu_f(bflo(zv[rr][jg][i])); v[2 * i + 1] = bfhi(yv[rr][jg][i]) * silu_f(bfhi(zv[rr][jg][i])); ss += v[2 * i] * v[2 * i] + v[2 * i + 1] * v[2 * i + 1]; }
                const float rs = rsqrtf(wave_sum(ss) * (1.0f / 512.0f) + EPS);
                u32x4 w;
#pragma unroll
                for (int i = 0; i < 4; ++i) w[i] = pk2(v[2 * i] * rs, v[2 * i + 1] * rs);
                *(u32x4*)(gn + (size_t)(t0 + rr) * DIN + c) = w;
            }
    }
}

#define XB_TMO      128
#define XB_XCNT(j)  (256  + 64 * (j))
#define XB_XSUB(j)  (1280 + 64 * (j))
#define XB_XGEN(j)  (2304 + 64 * (j))
#define XB_TOP      3328
#define XB_TOPGEN   3392
#define XCD_BAR_WORDS 3456
#define XB_SPIN_CAP (1u << 22)
DI unsigned xb_ld(unsigned* p)              { return __hip_atomic_load(p, __ATOMIC_RELAXED, __HIP_MEMORY_SCOPE_AGENT); }
DI unsigned xb_add(unsigned* p, unsigned v) { return __hip_atomic_fetch_add(p, v, __ATOMIC_RELAXED, __HIP_MEMORY_SCOPE_AGENT); }
DI unsigned xb_xcc_id() { return (unsigned)__builtin_amdgcn_s_getreg((3 << 11) | 20) & 0xFu; }
#define XB_SPIN(cond, bar) do { unsigned _sp = 0; while (cond) { __builtin_amdgcn_s_sleep(1); \
    if ((++_sp & 255u) == 0u) { if (xb_ld(&(bar)[XB_TMO])) break; if (_sp > XB_SPIN_CAP) { atomicAdd(&(bar)[XB_TMO], 1u); break; } } } } while (0)
struct XcdBarrier { unsigned* bar; unsigned x; volatile LAS unsigned* st; };
DI XcdBarrier xcd_barrier_post(unsigned* bar, volatile LAS unsigned* st) {
    XcdBarrier b; b.bar = bar; b.x = xb_xcc_id(); b.st = st;
    if (threadIdx.x == 0) (void)xb_add(&bar[XB_XCNT(b.x)], 1u);
    return b;
}
DI void xcd_barrier_complete(unsigned* bar, unsigned x, unsigned& nloc, unsigned& nx) {
    const unsigned G = gridDim.x * gridDim.y * gridDim.z;
    unsigned sum, cnt, mine, sp = 0u;
    for (;;) {
        sum = 0u; cnt = 0u; mine = 0u;
#pragma unroll
        for (unsigned j = 0; j < 16; ++j) { const unsigned c = xb_ld(&bar[XB_XCNT(j)]); sum += c; cnt += (c > 0u) ? 1u : 0u; mine = (j == x) ? c : mine; }
        if (sum == G) break;
        __builtin_amdgcn_s_sleep(1);
        if ((++sp & 255u) == 0u) { if (xb_ld(&bar[XB_TMO])) break; if (sp > XB_SPIN_CAP) { atomicAdd(&bar[XB_TMO], 1u); break; } }
    }
    nloc = mine > 0u ? mine : 1u; nx = cnt > 0u ? cnt : 1u;
}
DI void xcd_barrier(unsigned* bar_, volatile LAS unsigned* st_) {
    XcdBarrier b; b.bar = bar_; b.st = st_; b.x = 0;
    asm volatile("s_waitcnt vmcnt(0)" ::: "memory");
    __syncthreads();
    if (threadIdx.x == 0) {
        unsigned* bar = b.bar; b.x = xb_xcc_id();
        __builtin_amdgcn_s_waitcnt(0);
        unsigned nloc = b.st[0], nx = b.st[1];
        if (nloc == 0u) { xcd_barrier_complete(bar, b.x, nloc, nx); b.st[0] = nloc; b.st[1] = nx; }
        const unsigned old = xb_add(&bar[XB_XSUB(b.x)], 1u);
        const unsigned gen = old / nloc;
        if (old + 1u == (gen + 1u) * nloc) {
            __builtin_amdgcn_fence(__ATOMIC_RELEASE, "agent");
            asm volatile("s_waitcnt vmcnt(0)" ::: "memory");
            const unsigned og = xb_add(&bar[XB_TOP], 1u);
            const unsigned tg = og / nx;
            if (og + 1u == (tg + 1u) * nx) xb_add(&bar[XB_TOPGEN], 1u);
            else XB_SPIN(xb_ld(&bar[XB_TOPGEN]) == tg, bar);
            __builtin_amdgcn_fence(__ATOMIC_ACQUIRE, "agent");
            xb_add(&bar[XB_XGEN(b.x)], 1u);
            asm volatile("s_waitcnt vmcnt(0)" ::: "memory");
        } else {
            XB_SPIN(xb_ld(&bar[XB_XGEN(b.x)]) == gen, bar);
            __builtin_amdgcn_fence(__ATOMIC_ACQUIRE, "agent");
            asm volatile("s_waitcnt vmcnt(0)" ::: "memory");
        }
    }
    __syncthreads();
}

DI void grp_barrier(unsigned* ctl) {
    asm volatile("s_waitcnt vmcnt(0)" ::: "memory");
    __syncthreads();
    if (threadIdx.x == 0) {
        const unsigned g = blockIdx.x & 7u, nmemb = gridDim.x >> 3;
        unsigned* cnt = ctl + 8192 + 64 * g; unsigned* genw = ctl + 8192 + 64 * (8 + g);
        __builtin_amdgcn_fence(__ATOMIC_RELEASE, "agent");
        asm volatile("s_waitcnt vmcnt(0)" ::: "memory");
        const unsigned old = xb_add(cnt, 1u), gen = old / nmemb;
        if (old + 1u == (gen + 1u) * nmemb) xb_add(genw, 1u);
        else { unsigned sp = 0; while (xb_ld(genw) == gen && ++sp < (1u << 22)) __builtin_amdgcn_s_sleep(1); }
        __builtin_amdgcn_fence(__ATOMIC_ACQUIRE, "agent");
        asm volatile("s_waitcnt vmcnt(0)" ::: "memory");
    }
    __syncthreads();
}

__global__ void __launch_bounds__(512, 2) mega_fwd(Params pv) {
    extern __shared__ __attribute__((aligned(16))) unsigned char lds_raw[];
    ldsp lds = (ldsp)lds_raw;
    PPtr p = (PPtr)__builtin_amdgcn_kernarg_segment_ptr();
    cg::grid_group grid = cg::this_grid();
    constexpr int BAR_LDS_OFF = LDS_BYTES - 64;
    if (threadIdx.x < 16) ((LAS unsigned*)(lds + BAR_LDS_OFF))[threadIdx.x] = 0u;
    __syncthreads();
    (void)xcd_barrier_post((unsigned*)(p->ws + WS_CTL), (volatile LAS unsigned*)(lds + BAR_LDS_OFF));
#define GRID_SYNC() do { FRESH(p); xcd_barrier((unsigned*)(p->ws + WS_CTL), (volatile LAS unsigned*)(lds + BAR_LDS_OFF)); FRESH(p); } while (0)
#define GROUP_SYNC() do { if (gridDim.x == 256) { FRESH(p); grp_barrier((unsigned*)(p->ws + WS_CTL)); FRESH(p); } else GRID_SYNC(); } while (0)
#define mods ((const float*)(p->ws + WS_MODS))
#define hbuf ((bf16_t*)(p->ws + WS_H))

    { PHASE_IDS(); phase0(p, lds, tid, wave, lane); }
    if (p->out == nullptr) grid.sync();
    GRID_SYNC();

#pragma unroll 1
    for (int layer = 0; layer < DEPTH; ++layer) {
        const int j = layer >> 1;
#pragma unroll 1
        for (int sub = 0; sub < 3; ++sub) {
            const float* xin = (layer == 0 && sub == 0) ? p->x : p->out;
            const float* mods_ls = mods + (size_t)(layer * 36 + sub * 3) * 1024;
            const int qs = layer * 3 + sub;
            const bool fuse_norm = FUSE_NORM && (gridDim.x == 256);
            if (qs == 0 || !fuse_norm) {
                { PHASE_IDS(); norm_phase(xin, p->norm_gain + (size_t)(layer * 3 + sub) * DM, mods_ls, hbuf, wave, lane); }
                if (sub != 1) GROUP_SYNC(); else GRID_SYNC();
            }
            pg8::Gemm rg; float gs;
            if (sub != 1) {
                const int fi = layer * 2 + (sub == 2 ? 1 : 0);
                pg8::Gemm g{hbuf, (const bf16_t*)(p->ws + WS_WGU + fi * SZ_WGU), T, 2 * DFF, DM, DM};
                pg8::StaticOrder S; S.init(T, 2 * DFF, gridDim.x, opaque_bid());
                pg8::EpiSwiGLU E{(bf16_t*)(p->ws + WS_ACT)};
                REP(1) { pg8::gemm_phase<pg8::EpiSwiGLU>(lds, g, S, E);
                GROUP_SYNC(); }
                rg = pg8::Gemm{(const bf16_t*)(p->ws + WS_ACT), (const bf16_t*)(p->ws + WS_WDN + fi * SZ_WDN), T, DM, DFF, DFF}; gs = 0.5f;
            } else {
                const bool mla = (layer & 1) == 0;
                const int nrounds = mla ? 2 : 1;
#pragma unroll 1
                for (int round = 0; round < nrounds; ++round) REP(32) {
                    const int njobs = (mla && round == 1) ? 2 : 1;
#pragma unroll 1
                    for (int job = 0; job < njobs; ++job) {
                        pg8::Gemm g; pg8::EpiStore E;
                        if (!mla) { g = pg8::Gemm{hbuf, (const bf16_t*)(p->ws + WS_WIN + j * SZ_WIN), T, ZXW, DM, DM}; E = pg8::EpiStore{(bf16_t*)(p->ws + WS_ZX), ZXW, ZXW, nullptr}; }
                        else if (round == 0) { g = pg8::Gemm{hbuf, (const bf16_t*)(p->ws + WS_WA + j * SZ_WA), T, ADIMP, DM, DM}; E = pg8::EpiStore{(bf16_t*)(p->ws + WS_AOUT), ADIMP, ADIMP, nullptr}; }
                        else if (job == 0) { g = pg8::Gemm{(const bf16_t*)(p->ws + WS_AOUT), (const bf16_t*)(p->ws + WS_WQB + j * SZ_WQB), T, 1536, QL, ADIMP}; E = pg8::EpiStore{(bf16_t*)(p->ws + WS_QRAW), 1536, 1536, nullptr}; }
                        else { g = pg8::Gemm{(const bf16_t*)(p->ws + WS_AOUT) + QL, (const bf16_t*)(p->ws + WS_WKVB + j * SZ_WKVB), T, 2048, KVL, ADIMP}; E = pg8::EpiStore{(bf16_t*)(p->ws + WS_KVRAW), 2048, 2048, nullptr}; }
                        pg8::StaticOrder S; S.init(T, g.N, gridDim.x, opaque_bid());
                        pg8::gemm_phase<pg8::EpiStore>(lds, g, S, E);
                    }
                    GRID_SYNC();
                }
                if (mla) {
                    REP(16) { { PHASE_IDS(); mla_finalize(p, j, lds, tid, wave, lane); }
                    GRID_SYNC(); }
                    REP(2) { { PHASE_IDS(); attn_phase(p, j, lds, tid, wave, lane); }
                    GRID_SYNC(); }
                    rg = pg8::Gemm{(const bf16_t*)(p->ws + WS_O), (const bf16_t*)(p->ws + WS_WO + j * SZ_WO), T, DM, DM, DM}; gs = 1.0f;
                } else {
                    REP(16) { { PHASE_IDS(); conv_phase(p, j, lds, tid); }
                    GRID_SYNC(); }
                    REP(4) { { PHASE_IDS(); scan_phase(p, j, lds, tid, wave, lane); }
                    GRID_SYNC(); }
                    REP(16) { { PHASE_IDS(); gatenorm_phase(p, wave, lane); }
                    GRID_SYNC(); }
                    rg = pg8::Gemm{(const bf16_t*)(p->ws + WS_GN), (const bf16_t*)(p->ws + WS_WOUT + j * SZ_WOUT), T, DM, DIN, DIN}; gs = 1.0f;
                }
            }
            {
                pg8::StaticOrder S; S.init(T, DM, gridDim.x, opaque_bid());
                const bool has_next = qs < 11; const int qn = has_next ? qs + 1 : 0, ln = qn / 3, sn = qn % 3;
                pg8::EpiRes E{xin, p->out, mods_ls + 2048, hbuf, p->norm_gain + (size_t)qn * DM, mods + (size_t)(ln * 36 + sn * 3) * 1024,
                              (float*)(p->ws + WS_ROWSS), (unsigned*)(p->ws + WS_CTL) + 8192, gs, (has_next && fuse_norm) ? 1 : 0, 32u * (unsigned)(qs + 1), 0};
                pg8::gemm_phase<pg8::EpiRes>(lds, rg, S, E);
            }
            if (qs < 11) GROUP_SYNC();
        }
    }
}

extern "C" void kernel_launch(void* const* d_in, const int* in_sizes, int n_in, void* d_out, int out_size, void* d_ws, size_t ws_size, hipStream_t stream) {
    static int grid = 0;
    if (grid == 0) {
        if (n_in != 24 || out_size != T * DM || ws_size < WS_END) { fprintf(stderr, "kernel_launch: unexpected shapes (n_in %d, out %d, ws %zu, need %zu)\n", n_in, out_size, ws_size, (size_t)WS_END); grid = -1; return; }
        int dev = 0, cus = 0, per_cu = 0;
        (void)hipGetDevice(&dev);
        (void)hipDeviceGetAttribute(&cus, hipDeviceAttributeMultiprocessorCount, dev);
        (void)hipFuncSetAttribute((const void*)mega_fwd, hipFuncAttributeMaxDynamicSharedMemorySize, LDS_BYTES);
        (void)hipOccupancyMaxActiveBlocksPerMultiprocessor(&per_cu, (const void*)mega_fwd, 512, LDS_BYTES);
        if (per_cu < 1) { fprintf(stderr, "kernel_launch: occupancy query says %d blocks per CU\n", per_cu); per_cu = 1; }
        (void)hipGetLastError();
        grid = cus;
    }
    if (grid < 0) return;
    (void)hipMemsetAsync((unsigned char*)d_ws + WS_CTL, 0, 65536, stream);
    Params hp{};
        hp.x = (const float*)d_in[0]; hp.c = (const float*)d_in[1]; hp.pos = (const int*)d_in[2];
    hp.norm_gain = (const float*)d_in[3]; hp.ada_w = (const float*)d_in[4]; hp.ada_b = (const float*)d_in[5];
    hp.ffn_w_gu = (const float*)d_in[6]; hp.ffn_w_down = (const float*)d_in[7];
    hp.mla_w_a = (const float*)d_in[8]; hp.mla_q_a_gain = (const float*)d_in[9]; hp.mla_kv_a_gain = (const float*)d_in[10];
    hp.mla_w_qb = (const float*)d_in[11]; hp.mla_w_kvb = (const float*)d_in[12]; hp.mla_q_gain = (const float*)d_in[13];
    hp.mla_k_gain = (const float*)d_in[14]; hp.mla_w_o = (const float*)d_in[15];
    hp.ssd_w_in = (const float*)d_in[16]; hp.ssd_conv_w = (const float*)d_in[17]; hp.ssd_conv_b = (const float*)d_in[18];
    hp.ssd_dt_bias = (const float*)d_in[19]; hp.ssd_a_log = (const float*)d_in[20]; hp.ssd_d = (const float*)d_in[21];
    hp.ssd_norm_gain = (const float*)d_in[22]; hp.ssd_w_out = (const float*)d_in[23];
    hp.out = (float*)d_out; hp.ws = (unsigned char*)d_ws;
    void* args[] = {&hp};
    hipError_t e = hipLaunchCooperativeKernel((const void*)mega_fwd, dim3(grid), dim3(512), args, LDS_BYTES, stream);
    if (e != hipSuccess) fprintf(stderr, "kernel_launch: cooperative launch failed: %s (grid %d)\n", hipGetErrorString(e), grid);
}
```

```cpp
#include <hip/hip_runtime.h>
#include <hip/hip_cooperative_groups.h>
#include <cstdio>
#include <cstdint>
#include <cmath>
namespace cg = cooperative_groups;

#define LAS __attribute__((address_space(3)))
#define DI __device__ __forceinline__
typedef unsigned short bf16_t;
typedef short bf16x8 __attribute__((ext_vector_type(8)));
typedef short s16x4 __attribute__((ext_vector_type(4)));
typedef float f32x4 __attribute__((ext_vector_type(4)));
typedef float f32x2 __attribute__((ext_vector_type(2)));
typedef float f32x16 __attribute__((ext_vector_type(16)));
typedef unsigned u32x4 __attribute__((ext_vector_type(4)));
typedef unsigned u32x2 __attribute__((ext_vector_type(2)));
typedef __bf16 bf16x2_t __attribute__((ext_vector_type(2)));
typedef LAS unsigned char* ldsp;

constexpr int DM = 1024, NBATCH = 4, SEQ = 4096, T = NBATCH * SEQ, DEPTH = 4;
constexpr int DFF = 2816;
constexpr int HEADS = 16, QL = 384, KVL = 256, QKH = 96, ADIM = 672, ADIMP = 768;
constexpr int DIN = 2048, SSDH = 32, INP = 5152, INPP = 5376, ZXW = 5120, CONVD = 3072;
constexpr float EPS = 1e-6f;
constexpr float QSCALE = 0.10206207261596577f * 1.4426950408889634f;

constexpr size_t MiB = 1u << 20;
constexpr size_t WS_CTL = 0;
constexpr size_t WS_MODS = 1 * MiB;
constexpr size_t WS_ROWSS = 4 * MiB;
constexpr size_t WS_BIAS = 2 * MiB;
constexpr int NBIAS = 5632;
static_assert(WS_BIAS + (size_t)12 * 4 * NBIAS * 4 <= WS_ROWSS && WS_ROWSS + (size_t)T * 16 * 4 <= 6 * MiB, "ws map");
constexpr size_t WS_WGU = 6 * MiB;
constexpr size_t SZ_WGU = (size_t)5632 * 1024 * 2;
constexpr size_t WS_WDN = WS_WGU + 8 * SZ_WGU;
constexpr size_t SZ_WDN = (size_t)1024 * 2816 * 2;
constexpr size_t WS_WA = WS_WDN + 8 * SZ_WDN;
constexpr size_t SZ_WA = (size_t)ADIMP * 1024 * 2;
constexpr size_t WS_WQB = WS_WA + 2 * SZ_WA;
constexpr size_t SZ_WQB = (size_t)1536 * 384 * 2;
constexpr size_t WS_WKVB = WS_WQB + 2 * SZ_WQB;
constexpr size_t SZ_WKVB = (size_t)2048 * 256 * 2;
constexpr size_t WS_WO = WS_WKVB + 2 * SZ_WKVB;
constexpr size_t SZ_WO = (size_t)1024 * 1024 * 2;
constexpr size_t WS_WIN = WS_WO + 2 * SZ_WO;
constexpr size_t SZ_WIN = (size_t)INPP * 1024 * 2;
constexpr size_t WS_WOUT = WS_WIN + 2 * SZ_WIN;
constexpr size_t SZ_WOUT = (size_t)1024 * 2048 * 2;
constexpr size_t WS_H = WS_WOUT + 2 * SZ_WOUT;
constexpr size_t WS_SCR = WS_H + (size_t)T * 1024 * 2;
constexpr size_t WS_ACT = WS_SCR;
constexpr size_t WS_AOUT = WS_SCR;
constexpr size_t WS_QRAW = WS_AOUT + (size_t)T * ADIMP * 2;
constexpr size_t WS_KVRAW = WS_QRAW + (size_t)T * 1536 * 2;
constexpr size_t WS_QB = WS_KVRAW + (size_t)T * 2048 * 2;
constexpr size_t WS_KB = WS_QB + (size_t)T * 1536 * 2;
constexpr size_t WS_VT = WS_KB + (size_t)T * 1536 * 2;
constexpr size_t WS_O = WS_VT + (size_t)T * 1024 * 2;
constexpr size_t WS_MLA_END = WS_O + (size_t)T * 1024 * 2;
constexpr size_t WS_ZX = WS_SCR;
constexpr size_t WS_DTRAW = WS_ZX + (size_t)T * ZXW * 2;
constexpr size_t WS_XT = WS_DTRAW + (size_t)T * 32 * 4;
constexpr size_t WS_GN = WS_XT;
constexpr size_t WS_BC = WS_XT + (size_t)T * 2048 * 2;
constexpr size_t WS_CC = WS_BC + (size_t)T * 512 * 2;
constexpr size_t WS_BT = WS_CC + (size_t)T * 512 * 2;
constexpr size_t WS_Y = WS_BT + (size_t)T * 512 * 2;
constexpr size_t WS_SSD_END = WS_Y + (size_t)T * 2048 * 2;
constexpr size_t WS_END = (WS_SSD_END > WS_MLA_END ? WS_SSD_END : WS_MLA_END);

constexpr int LDS_BYTES = 147456;
constexpr bool FUSE_NORM = false;
#ifndef DUP
#define DUP 0
#endif
#define REP(mask) _Pragma("unroll 1") for (int rep_ = 0; rep_ < ((DUP & (mask)) ? 2 : 1); ++rep_)

struct Params {
    const float* x; const float* c; const int* pos; const float* norm_gain; const float* ada_w; const float* ada_b;
    const float* ffn_w_gu; const float* ffn_w_down;
    const float* mla_w_a; const float* mla_q_a_gain; const float* mla_kv_a_gain; const float* mla_w_qb; const float* mla_w_kvb;
    const float* mla_q_gain; const float* mla_k_gain; const float* mla_w_o;
    const float* ssd_w_in; const float* ssd_conv_w; const float* ssd_conv_b; const float* ssd_dt_bias; const float* ssd_a_log;
    const float* ssd_d; const float* ssd_norm_gain; const float* ssd_w_out;
    float* out; unsigned char* ws;
};

typedef const __attribute__((address_space(4))) Params* PPtr;
#define FRESH(p) asm volatile("" : "+s"(p))
DI unsigned pk2(float lo, float hi) { f32x2 v = {lo, hi}; bf16x2_t b = __builtin_convertvector(v, bf16x2_t); return __builtin_bit_cast(unsigned, b); }
DI bf16_t f2bf(float v) { return (bf16_t)(pk2(v, 0.f) & 0xffffu); }
DI float bflo(unsigned w) { return __uint_as_float(w << 16); }
DI float bfhi(unsigned w) { return __uint_as_float(w & 0xffff0000u); }
DI int opaque_tid() { int t = threadIdx.x; asm volatile("" : "+v"(t)); return t; }
DI int opaque_bid() { int t = blockIdx.x; asm volatile("" : "+s"(t)); return t; }
#define PHASE_IDS() const int tid = opaque_tid(), lane = tid & 63, wave = __builtin_amdgcn_readfirstlane(tid >> 6); (void)lane; (void)wave
#define LDS_BARRIER() do { asm volatile("s_waitcnt lgkmcnt(0)" ::: "memory"); __builtin_amdgcn_s_barrier(); asm volatile("" ::: "memory"); } while (0)
DI float wave_sum(float v) {
#pragma unroll
    for (int o = 1; o < 64; o <<= 1) v += __shfl_xor(v, o);
    return v;
}
DI float silu_f(float g) { return g * __builtin_amdgcn_rcpf(1.0f + __expf(-g)); }
DI int crow(int reg, int h) { return (reg & 3) + 8 * (reg >> 2) + 4 * h; }
#define MFMA32(a, b, c) __builtin_amdgcn_mfma_f32_32x32x16_bf16((a), (b), (c), 0, 0, 0)
DI bf16x8 pack8(const f32x16& x, int s) {
    u32x4 p;
    p[0] = pk2(x[8 * s + 0], x[8 * s + 1]); p[1] = pk2(x[8 * s + 2], x[8 * s + 3]);
    p[2] = pk2(x[8 * s + 4], x[8 * s + 5]); p[3] = pk2(x[8 * s + 6], x[8 * s + 7]);
    return __builtin_bit_cast(bf16x8, p);
}

namespace pg8 {
constexpr int BM = 256, BK = 64, HALF = 128, HTB = HALF * BK * 2, STAGE_BYTES = 8 * HTB, NXCD = 8, WGM = 8;
DI int lds_byte(int r, int c) { const int st = (r >> 4) * 2 + (c >> 5), rr = r & 15, cc = c & 31, ob = rr * 64 + cc * 2; return st * 1024 + (ob ^ (((ob >> 9) & 1) << 5)); }
DI void stage_rc(int b, int& R, int& C) { const int st = b / 1024, sb = b % 1024, swz = sb ^ (((sb >> 9) & 1) << 5); R = (st >> 1) * 16 + swz / 64; C = (st & 1) * 32 + (swz % 64) / 2; }
DI int perm32(int rho) { const int n = rho >> 4, i = rho & 15; return 8 * (i >> 2) + 4 * n + (i & 3); }

struct Unit { int pm, pn; };
struct Gemm { const bf16_t* A; const bf16_t* Bt; int M, N, K, lda; };

struct StaticOrder {
    int nM, nN, nwg, G, c;
    DI void init(int M, int N, int G_, int c_) { nM = M / BM; nN = N / BM; nwg = nM * nN; G = G_; c = c_; }
    DI bool next(int i, Unit& u) const {
        const long L = (long)i * G + c; if (L >= nwg) return false;
        int wgid = (int)L; { const int q = nwg / NXCD, r = nwg % NXCD, xcd = wgid % NXCD, off = wgid / NXCD; wgid = (xcd < r ? xcd * (q + 1) : r * (q + 1) + (xcd - r) * q) + off; }
        const int nig = WGM * nN, gid = wgid / nig, fm = gid * WGM, gsz = (nM - fm) < WGM ? (nM - fm) : WGM;
        u.pm = fm + ((wgid % nig) % gsz); u.pn = (wgid % nig) / gsz; return true;
    }
};

struct EpiSwiGLU {
    static constexpr bool PERM = true;
    bf16_t* O;
    DI void operator()(const f32x4 (&acc)[2][2][4][2], const Unit& u, int wr, int wc, int fr, int fq) const {
        const int row0 = u.pm * BM + wr * 64 + fr; const int col0 = (u.pn * BM + wc * 32 + 8 * fq) >> 1;
#pragma unroll
        for (int ai = 0; ai < 2; ++ai)
#pragma unroll
            for (int m = 0; m < 4; ++m) { bf16_t* rowp = O + (size_t)(row0 + ai * HALF + m * 16) * DFF + col0;
#pragma unroll
                for (int bj = 0; bj < 2; ++bj) { const f32x4 v0 = acc[ai][bj][m][0], v1 = acc[ai][bj][m][1];
                    u32x2 w; w.x = pk2(silu_f(v0[0]) * v0[1], silu_f(v0[2]) * v0[3]); w.y = pk2(silu_f(v1[0]) * v1[1], silu_f(v1[2]) * v1[3]);
                    *(u32x2*)(rowp + bj * 64) = w; } }
    }
};
struct EpiStore {
    static constexpr bool PERM = true;
    bf16_t* O; int ldc; int nbf; float* dt;
    DI void operator()(const f32x4 (&acc)[2][2][4][2], const Unit& u, int wr, int wc, int fr, int fq) const {
        const int row0 = u.pm * BM + wr * 64 + fr; const int c0 = u.pn * BM + wc * 32 + 8 * fq;
#pragma unroll
        for (int ai = 0; ai < 2; ++ai)
#pragma unroll
            for (int m = 0; m < 4; ++m) { const int row = row0 + ai * HALF + m * 16;
#pragma unroll
                for (int bj = 0; bj < 2; ++bj) { const int c = c0 + bj * HALF; const f32x4 v0 = acc[ai][bj][m][0], v1 = acc[ai][bj][m][1];
                    if (c < nbf) { u32x4 w; w.x = pk2(v0[0], v0[1]); w.y = pk2(v0[2], v0[3]); w.z = pk2(v1[0], v1[1]); w.w = pk2(v1[2], v1[3]);
                        *(u32x4*)(O + (size_t)row * ldc + c) = w; }
                    else if (dt != nullptr && c < nbf + 32) { float* d = dt + (size_t)row * 32 + (c - nbf); *(f32x4*)d = v0; *(f32x4*)(d + 4) = v1; } } }
    }
};
struct EpiRes {
    static constexpr bool PERM = false;
    const float* xin; float* xout; const float* gate; bf16_t* xb; const float* gain_n; const float* mods_n; float* slots; unsigned* cnt; float gs; int fused; unsigned expect; int pad_;
    DI void operator()(f32x4 (&acc)[2][2][4][2], const Unit& u, int wr, int wc, int fr, int fq) const {
        const int col0 = u.pn * BM + wc * 32 + 4 * fq; const float* g = gate + (size_t)(u.pm >> 4) * 9216;
        {
            f32x4 gv[2][2];
#pragma unroll
            for (int bj = 0; bj < 2; ++bj)
#pragma unroll
                for (int n = 0; n < 2; ++n) gv[bj][n] = *(const f32x4*)(g + col0 + bj * HALF + n * 16) * gs;
#pragma unroll
            for (int ai = 0; ai < 2; ++ai)
#pragma unroll
                for (int m = 0; m < 4; ++m) { const int row = u.pm * BM + ai * HALF + wr * 64 + m * 16 + fr; const size_t off = (size_t)row * DM + col0;
                    float sq = 0.f;
#pragma unroll
                    for (int bj = 0; bj < 2; ++bj)
#pragma unroll
                        for (int n = 0; n < 2; ++n) { const f32x4 xi = *(const f32x4*)(xin + off + bj * HALF + n * 16);
                            const f32x4 o = xi + gv[bj][n] * acc[ai][bj][m][n];
                            if (!fused) *(f32x4*)(xout + off + bj * HALF + n * 16) = o;
                            acc[ai][bj][m][n] = o;
                            sq += (o[0] * o[0] + o[1] * o[1]) + (o[2] * o[2] + o[3] * o[3]); }
                    if (fused) { sq += __shfl_xor(sq, 16); sq += __shfl_xor(sq, 32);
                        if (fq == 0) __hip_atomic_store(slots + (size_t)row * 16 + u.pn * 4 + wc, sq, __ATOMIC_RELAXED, __HIP_MEMORY_SCOPE_AGENT); }
                    if (m & 1) asm volatile("" ::: "memory"); }
        }
        if (!fused) return;
        asm volatile("s_waitcnt vmcnt(0)" ::: "memory");
        unsigned* c = cnt + 64 * u.pm;
        if (fr == 0 && fq == 0) __hip_atomic_fetch_add(c, 1u, __ATOMIC_RELAXED, __HIP_MEMORY_SCOPE_AGENT);
#pragma unroll
        for (int ai = 0; ai < 2; ++ai)
#pragma unroll
            for (int m = 0; m < 4; ++m) { const size_t off = (size_t)(u.pm * BM + ai * HALF + wr * 64 + m * 16 + fr) * DM + col0;
#pragma unroll
                for (int bj = 0; bj < 2; ++bj)
#pragma unroll
                    for (int n = 0; n < 2; ++n) *(f32x4*)(xout + off + bj * HALF + n * 16) = acc[ai][bj][m][n]; }
        if (fr == 0 && fq == 0) {
            unsigned it = 0;
            while (__hip_atomic_load(c, __ATOMIC_RELAXED, __HIP_MEMORY_SCOPE_AGENT) < expect && ++it < (1u << 21)) __builtin_amdgcn_s_sleep(2);
        }
        asm volatile("" ::: "memory");
        const float* sh = mods_n + (size_t)(u.pm >> 4) * 9216;
        f32x4 gsc[2][2], shv[2][2];
#pragma unroll
        for (int bj = 0; bj < 2; ++bj)
#pragma unroll
            for (int n = 0; n < 2; ++n) { const int c4 = col0 + bj * HALF + n * 16;
                gsc[bj][n] = *(const f32x4*)(gain_n + c4) * (*(const f32x4*)(sh + 1024 + c4) + 1.0f); shv[bj][n] = *(const f32x4*)(sh + c4); }
#pragma unroll
        for (int ai = 0; ai < 2; ++ai)
#pragma unroll
            for (int m = 0; m < 4; ++m) { const int row = u.pm * BM + ai * HALF + wr * 64 + m * 16 + fr; const size_t off = (size_t)row * DM + col0;
                const float* sp = slots + (size_t)row * 16 + 4 * fq;
                float t = (__hip_atomic_load(sp, __ATOMIC_RELAXED, __HIP_MEMORY_SCOPE_AGENT) + __hip_atomic_load(sp + 1, __ATOMIC_RELAXED, __HIP_MEMORY_SCOPE_AGENT))
                        + (__hip_atomic_load(sp + 2, __ATOMIC_RELAXED, __HIP_MEMORY_SCOPE_AGENT) + __hip_atomic_load(sp + 3, __ATOMIC_RELAXED, __HIP_MEMORY_SCOPE_AGENT));
                t += __shfl_xor(t, 16); t += __shfl_xor(t, 32);
                const float rs = rsqrtf(t * (1.0f / DM) + EPS);
#pragma unroll
                for (int bj = 0; bj < 2; ++bj)
#pragma unroll
                    for (int n = 0; n < 2; ++n) { const f32x4 hv = acc[ai][bj][m][n] * rs * gsc[bj][n] + shv[bj][n];
                        u32x2 w; w.x = pk2(hv[0], hv[1]); w.y = pk2(hv[2], hv[3]); *(u32x2*)(xb + off + bj * HALF + n * 16) = w; } }
    }
};

template <class Epi>
DI void gemm_phase(ldsp lds, const Gemm g, const StaticOrder S, const Epi E) {
    const int tid = opaque_tid(), wid = __builtin_amdgcn_readfirstlane(tid >> 6), lane = tid & 63, wr = wid >> 2, wc = wid & 3, fr = lane & 15, fq = lane >> 4;
    const int K = g.K, nt = K / BK, lda = g.lda;
    unsigned voffA[2], voffB[2];
#pragma unroll
    for (int i = 0; i < 2; ++i) { int R, C; stage_rc(tid * 16 + i * 8192, R, C); const int Rb = Epi::PERM ? ((R & ~31) + perm32(R & 31)) : R;
        voffA[i] = (unsigned)(R * lda + C) * 2u; voffB[i] = (unsigned)(Rb * K + C) * 2u; }
    const size_t kstep = (size_t)(BK * 2);
    const size_t hstepA = (size_t)HALF * lda * 2, hstepB = (size_t)HALF * K * 2;
    const size_t tstepA = 2 * hstepA, tstepB = 2 * hstepB;
    const unsigned ldsw = (unsigned)wid * 1024u;
    const int aoff = lds_byte(wr * 64 + fr, fq * 8), boff = lds_byte(wc * 32 + fr, fq * 8);
#define PG8_SA(b, h) (((b) * 2 + (h)) * HTB)
#define PG8_SB(b, h) ((4 + (b) * 2 + (h)) * HTB)
#define PG8_STAGE(bufoff, gbase, voff) do { _Pragma("unroll") for (int _i = 0; _i < 2; ++_i) \
        __builtin_amdgcn_global_load_lds((const unsigned*)((const char*)(gbase) + (voff)[_i]), (LAS unsigned*)(lds + (bufoff) + ldsw + _i * 8192), 16, 0, 0); } while (0)
#define PG8_LDA(dst, b, h) do { _Pragma("unroll") for (int m = 0; m < 4; ++m) _Pragma("unroll") for (int k = 0; k < 2; ++k) dst[m][k] = *(const LAS bf16x8*)(lds + PG8_SA(b, h) + aoff + m * 2048 + k * 1024); } while (0)
#define PG8_LDB(dst, b, h) do { _Pragma("unroll") for (int n = 0; n < 2; ++n) _Pragma("unroll") for (int k = 0; k < 2; ++k) dst[n][k] = *(const LAS bf16x8*)(lds + PG8_SB(b, h) + boff + n * 2048 + k * 1024); } while (0)
#define PG8_MMA(ai, bj, At, Bt) do { __builtin_amdgcn_s_setprio(1); _Pragma("unroll") for (int m = 0; m < 4; ++m) _Pragma("unroll") for (int n = 0; n < 2; ++n) _Pragma("unroll") for (int k = 0; k < 2; ++k) \
        acc[ai][bj][m][n] = __builtin_amdgcn_mfma_f32_16x16x32_bf16(Bt[n][k], At[m][k], acc[ai][bj][m][n], 0, 0, 0); __builtin_amdgcn_s_setprio(0); } while (0)
#define PG8_WAIT_V(n) asm volatile("s_waitcnt vmcnt(" #n ")" ::: "memory")
#define PG8_WAIT_L(n) asm volatile("s_waitcnt lgkmcnt(" #n ")" ::: "memory")
#define PG8_BAR __builtin_amdgcn_s_barrier()
#define PG8_SCHED __builtin_amdgcn_sched_barrier(0)
    Unit cur, nxt; int ui = 0;
    if (!S.next(0, cur)) return;
    f32x4 acc[2][2][4][2];
#pragma unroll
    for (int a = 0; a < 2; ++a)
#pragma unroll
        for (int b = 0; b < 2; ++b)
#pragma unroll
            for (int m = 0; m < 4; ++m)
#pragma unroll
                for (int n = 0; n < 2; ++n) acc[a][b][m][n] = (f32x4){0.f, 0.f, 0.f, 0.f};
    bf16x8 At[4][2], B0[2][2], B1[2][2];
    const char* cA = (const char*)g.A + (size_t)cur.pm * tstepA; const char* cB = (const char*)g.Bt + (size_t)cur.pn * tstepB;
    PG8_STAGE(PG8_SB(0, 0), cB, voffB); PG8_STAGE(PG8_SB(0, 1), cB + hstepB, voffB); PG8_STAGE(PG8_SA(0, 0), cA, voffA); PG8_STAGE(PG8_SA(0, 1), cA + hstepA, voffA);
    if (wr == 1) PG8_BAR;
    PG8_WAIT_V(2); PG8_BAR;
    PG8_STAGE(PG8_SB(1, 0), cB + kstep, voffB); PG8_STAGE(PG8_SA(1, 0), cA + kstep, voffA); PG8_STAGE(PG8_SB(1, 1), cB + hstepB + kstep, voffB);
    PG8_WAIT_V(6); PG8_BAR;
    for (;;) {
        const bool has_next = S.next(ui + 1, nxt);
        const char* nA = has_next ? (const char*)g.A + (size_t)nxt.pm * tstepA : cA; const char* nB = has_next ? (const char*)g.Bt + (size_t)nxt.pn * tstepB : cB;
        for (int t = 0; t < nt; t += 2) {
            const bool last = (t == nt - 2);
            const char* a1 = cA + (size_t)(t + 1) * kstep;
            const char* a2 = last ? nA : cA + (size_t)(t + 2) * kstep; const char* b2 = last ? nB : cB + (size_t)(t + 2) * kstep;
            const char* a3 = a2 + kstep; const char* b3 = b2 + kstep;
            PG8_LDB(B0, 0, 0); PG8_LDB(B1, 0, 1); PG8_SCHED; PG8_LDA(At, 0, 0); PG8_STAGE(PG8_SA(1, 1), a1 + hstepA, voffA);
            PG8_WAIT_V(8); PG8_WAIT_L(0); PG8_BAR; PG8_MMA(0, 0, At, B0); PG8_MMA(0, 1, At, B1); PG8_BAR; PG8_SCHED;
            PG8_LDA(At, 0, 1); PG8_STAGE(PG8_SB(0, 0), b2, voffB); PG8_STAGE(PG8_SB(0, 1), b2 + hstepB, voffB); PG8_STAGE(PG8_SA(0, 0), a2, voffA);
            PG8_WAIT_V(8); PG8_WAIT_L(0); PG8_BAR; PG8_MMA(1, 0, At, B0); PG8_MMA(1, 1, At, B1); PG8_BAR; PG8_SCHED;
            PG8_LDB(B0, 1, 0); PG8_LDB(B1, 1, 1); PG8_SCHED; PG8_LDA(At, 1, 0); PG8_STAGE(PG8_SA(0, 1), a2 + hstepA, voffA);
            PG8_WAIT_V(8); PG8_WAIT_L(0); PG8_BAR; PG8_MMA(0, 0, At, B0); PG8_MMA(0, 1, At, B1); PG8_BAR; PG8_SCHED;
            PG8_LDA(At, 1, 1); PG8_STAGE(PG8_SB(1, 0), b3, voffB); PG8_STAGE(PG8_SB(1, 1), b3 + hstepB, voffB); PG8_STAGE(PG8_SA(1, 0), a3, voffA);
            PG8_WAIT_V(8); PG8_WAIT_L(0); PG8_BAR; PG8_MMA(1, 0, At, B0); PG8_MMA(1, 1, At, B1); PG8_BAR; PG8_SCHED;
        }
        if (wr == 0) PG8_BAR;
        E(acc, cur, wr, wc, fr, fq);
        if (!has_next) break;
#pragma unroll
        for (int a = 0; a < 2; ++a)
#pragma unroll
            for (int b = 0; b < 2; ++b)
#pragma unroll
                for (int m = 0; m < 4; ++m)
#pragma unroll
                    for (int n = 0; n < 2; ++n) acc[a][b][m][n] = (f32x4){0.f, 0.f, 0.f, 0.f};
        cur = nxt; cA = nA; cB = nB; ++ui;
        if (wr == 1) PG8_BAR;
    }
    PG8_WAIT_V(0);
    PG8_BAR;
#undef PG8_SA
#undef PG8_SB
#undef PG8_STAGE
#undef PG8_LDA
#undef PG8_LDB
#undef PG8_MMA
#undef PG8_WAIT_V
#undef PG8_WAIT_L
#undef PG8_BAR
#undef PG8_SCHED
}
}

DI void cvt_item(const float* W, int K, int N, bf16_t* WT, const float* kgain, int half, LAS float* scr, int item, int lane) {
    const int nblk = N / 32, kb = item / nblk, nb = item % nblk, k0 = 64 * kb, n0 = 32 * nb;
    const int kq = lane >> 3, nq = lane & 7;
    f32x4 v[8];
#pragma unroll
    for (int i = 0; i < 8; ++i) v[i] = *(const f32x4*)(W + (size_t)(k0 + 8 * i + kq) * N + n0 + 4 * nq);
#pragma unroll
    for (int i = 0; i < 8; ++i) { const int kk = 8 * i + kq; const float gk = kgain ? kgain[k0 + kk] : 1.0f;
        LAS float* d = scr + kk * 33 + 4 * nq; d[0] = v[i][0] * gk; d[1] = v[i][1] * gk; d[2] = v[i][2] * gk; d[3] = v[i][3] * gk; }
    asm volatile("s_waitcnt lgkmcnt(0)" ::: "memory");
    const int c = lane & 7;
#pragma unroll
    for (int j = 0; j < 4; ++j) { const int n = (lane >> 3) + 8 * j; const LAS float* s = scr + (8 * c) * 33 + n;
        u32x4 o; o.x = pk2(s[0 * 33], s[1 * 33]); o.y = pk2(s[2 * 33], s[3 * 33]); o.z = pk2(s[4 * 33], s[5 * 33]); o.w = pk2(s[6 * 33], s[7 * 33]);
        const int ns = n0 + n; const int nd = half ? (ns < half ? 2 * ns : 2 * (ns - half) + 1) : ns;
        *(u32x4*)(WT + (size_t)nd * K + k0 + 8 * c) = o; }
    asm volatile("s_waitcnt lgkmcnt(0)" ::: "memory");
}

DI void phase0(PPtr p, ldsp lds, int tid, int wave, int lane) {
    LAS float* sc = (LAS float*)lds;
    LAS float* red = (LAS float*)(lds + 16384);
    LAS float* red2 = (LAS float*)(lds + 16384 + 32768);
    for (int i = tid; i < 4096; i += 512) { const float v = p->c[i]; sc[i] = v / (1.0f + __expf(-v)); }
    __syncthreads();
    float* mods = (float*)(p->ws + WS_MODS);
    const int cgp = tid & 7, ks = tid >> 3;
    for (int item = blockIdx.x; item < 1152; item += gridDim.x) {
        const int ge0 = item * 32, l = ge0 / 9216, e0 = ge0 % 9216;
        const float* W = p->ada_w + (size_t)l * 1024 * 9216 + e0 + 4 * cgp;
        f32x4 acc[4];
#pragma unroll
        for (int b = 0; b < 4; ++b) acc[b] = (f32x4){0.f, 0.f, 0.f, 0.f};
        f32x4 wv[16];
#pragma unroll
        for (int kk = 0; kk < 16; ++kk) wv[kk] = *(const f32x4*)(W + (size_t)(ks * 16 + kk) * 9216);
#pragma unroll
        for (int kk = 0; kk < 16; ++kk) { const int k = ks * 16 + kk;
#pragma unroll
            for (int b = 0; b < 4; ++b) acc[b] += wv[kk] * sc[b * 1024 + k]; }
#pragma unroll
        for (int b = 0; b < 4; ++b) *(LAS f32x4*)(red + ks * 128 + b * 32 + 4 * cgp) = acc[b];
        __syncthreads();
        { const int oc = tid & 127, part = tid >> 7; float s = 0.f;
#pragma unroll
          for (int j = 0; j < 16; ++j) s += red[(part * 16 + j) * 128 + oc];
          red2[part * 128 + oc] = s; }
        __syncthreads();
        if (tid < 128) { const float s = (red2[tid] + red2[128 + tid]) + (red2[256 + tid] + red2[384 + tid]);
            const int b = tid >> 5, col = tid & 31;
            mods[(size_t)(l * 4 + b) * 9216 + e0 + col] = s + p->ada_b[l * 9216 + e0 + col]; }
    }
    LAS float* scr = (LAS float*)(lds + 65536 + wave * 8448);
    const int gw = blockIdx.x * 8 + wave, ngw = gridDim.x * 8;
    constexpr int I_GU = 16 * 176, I_DN = 44 * 32, I_A = 16 * 21, I_QB = 6 * 48, I_KVB = 4 * 64, I_O = 16 * 32, I_IN = 16 * 161, I_OUT = 32 * 32;
    constexpr int NITEMS = 8 * I_GU + 8 * I_DN + 2 * (I_A + I_QB + I_KVB + I_O + I_IN + I_OUT);
    for (int it = gw; it < NITEMS; it += ngw) {
        int r = it; const float* src; bf16_t* dst; const float* kg = nullptr; int K, N, half = 0, li, m;
        if (r < 8 * I_GU) { m = r / I_GU; li = r % I_GU; K = 1024; N = 5632; half = 2816; src = p->ffn_w_gu + (size_t)m * 1024 * 5632; dst = (bf16_t*)(p->ws + WS_WGU + m * SZ_WGU); }
        else if ((r -= 8 * I_GU) < 8 * I_DN) { m = r / I_DN; li = r % I_DN; K = 2816; N = 1024; src = p->ffn_w_down + (size_t)m * 2816 * 1024; dst = (bf16_t*)(p->ws + WS_WDN + m * SZ_WDN); }
        else if ((r -= 8 * I_DN) < 2 * I_A) { m = r / I_A; li = r % I_A; K = 1024; N = ADIM; src = p->mla_w_a + (size_t)m * 1024 * ADIM; dst = (bf16_t*)(p->ws + WS_WA + m * SZ_WA); }
        else if ((r -= 2 * I_A) < 2 * I_QB) { m = r / I_QB; li = r % I_QB; K = 384; N = 1536; src = p->mla_w_qb + (size_t)m * 384 * 1536; dst = (bf16_t*)(p->ws + WS_WQB + m * SZ_WQB); kg = p->mla_q_a_gain + m * 384; }
        else if ((r -= 2 * I_QB) < 2 * I_KVB) { m = r / I_KVB; li = r % I_KVB; K = 256; N = 2048; src = p->mla_w_kvb + (size_t)m * 256 * 2048; dst = (bf16_t*)(p->ws + WS_WKVB + m * SZ_WKVB); kg = p->mla_kv_a_gain + m * 256; }
        else if ((r -= 2 * I_KVB) < 2 * I_O) { m = r / I_O; li = r % I_O; K = 1024; N = 1024; src = p->mla_w_o + (size_t)m * 1024 * 1024; dst = (bf16_t*)(p->ws + WS_WO + m * SZ_WO); }
        else if ((r -= 2 * I_O) < 2 * I_IN) { m = r / I_IN; li = r % I_IN; K = 1024; N = INP; src = p->ssd_w_in + (size_t)m * 1024 * INP; dst = (bf16_t*)(p->ws + WS_WIN + m * SZ_WIN); }
        else { r -= 2 * I_IN; m = r / I_OUT; li = r % I_OUT; K = 2048; N = 1024; src = p->ssd_w_out + (size_t)m * 2048 * 1024; dst = (bf16_t*)(p->ws + WS_WOUT + m * SZ_WOUT); kg = p->ssd_norm_gain + m * 2048; }
        cvt_item(src, K, N, dst, kg, half, scr, li, lane);
    }
    constexpr int PA = (ADIMP - ADIM) * 1024 * 2 / 16, PI = (INPP - INP) * 1024 * 2 / 16;
    const u32x4 z4 = {0u, 0u, 0u, 0u};
    for (int i = blockIdx.x * 512 + tid; i < 2 * (PA + PI); i += gridDim.x * 512) {
        int r = i; unsigned char* d;
        if (r < 2 * PA) { const int m = r / PA; d = p->ws + WS_WA + m * SZ_WA + (size_t)ADIM * 1024 * 2 + (size_t)(r % PA) * 16; }
        else { r -= 2 * PA; const int m = r / PI; d = p->ws + WS_WIN + m * SZ_WIN + (size_t)INP * 1024 * 2 + (size_t)(r % PI) * 16; }
        *(u32x4*)d = z4;
    }
}

DI void norm_phase(const float* xin, const float* gain, const float* mods_ls, bf16_t* h, int wave, int lane) {
    const int vb = (gridDim.x == 256) ? ((blockIdx.x & 7) * 32 + (blockIdx.x >> 3)) : (int)blockIdx.x;
    const int gw = vb * 8 + wave, ngw = gridDim.x * 8;
    for (int blk = gw; blk < T / 8; blk += ngw) {
        const int m0 = blk * 8, b = m0 >> 12;
        const float* shift = mods_ls + (size_t)b * 9216; const float* scale = shift + 1024;
        f32x4 gsc[4], sh[4];
#pragma unroll
        for (int j = 0; j < 4; ++j) { const int c = 4 * lane + 256 * j; gsc[j] = *(const f32x4*)(gain + c) * (*(const f32x4*)(scale + c) + 1.0f); sh[j] = *(const f32x4*)(shift + c); }
#pragma unroll 2
        for (int r = 0; r < 8; ++r) {
            const float* xr = xin + (size_t)(m0 + r) * DM + 4 * lane;
            f32x4 v[4]; float ss = 0.f;
#pragma unroll
            for (int j = 0; j < 4; ++j) { v[j] = *(const f32x4*)(xr + 256 * j); ss += (v[j].x * v[j].x + v[j].y * v[j].y) + (v[j].z * v[j].z + v[j].w * v[j].w); }
            const float rstd = rsqrtf(wave_sum(ss) * (1.0f / DM) + EPS);
            bf16_t* hr = h + (size_t)(m0 + r) * DM + 4 * lane;
#pragma unroll
            for (int j = 0; j < 4; ++j) { const f32x4 o = v[j] * rstd * gsc[j] + sh[j]; u32x2 w; w.x = pk2(o.x, o.y); w.y = pk2(o.z, o.w); *(u32x2*)(hr + 256 * j) = w; }
        }
    }
}

DI void mla_finalize(PPtr p, int j, ldsp lds, int tid, int wave, int lane) {
    const bf16_t* aout = (const bf16_t*)(p->ws + WS_AOUT); const bf16_t* qraw = (const bf16_t*)(p->ws + WS_QRAW); const bf16_t* kvraw = (const bf16_t*)(p->ws + WS_KVRAW);
    bf16_t* Qb = (bf16_t*)(p->ws + WS_QB); bf16_t* Kb = (bf16_t*)(p->ws + WS_KB); bf16_t* Vt = (bf16_t*)(p->ws + WS_VT);
    const float* qg = p->mla_q_gain + j * QKH; const float* kg = p->mla_k_gain + j * QKH;
    constexpr int VTP = 40;
    const int head = lane >> 2, sub = lane & 3;
    for (int item = blockIdx.x; item < T / 32; item += gridDim.x) {
        const int t0 = item * 32, b = t0 >> 12, s0 = t0 & 4095;
        for (int rr = 0; rr < 4; ++rr) {
            const int tok = wave * 4 + rr, t = t0 + tok;
            float ssq = 0.f, sskv = 0.f;
            if (lane < 48) { const u32x4 w = *(const u32x4*)(aout + (size_t)t * ADIMP + 8 * lane);
#pragma unroll
                for (int i = 0; i < 4; ++i) { const float a = bflo(w[i]), c = bfhi(w[i]); ssq += a * a + c * c; } }
            if (lane < 32) { const u32x4 w = *(const u32x4*)(aout + (size_t)t * ADIMP + QL + 8 * lane);
#pragma unroll
                for (int i = 0; i < 4; ++i) { const float a = bflo(w[i]), c = bfhi(w[i]); sskv += a * a + c * c; } }
            const float rq = rsqrtf(wave_sum(ssq) * (1.0f / QL) + EPS), rkv = rsqrtf(wave_sum(sskv) * (1.0f / KVL) + EPS);
            float cs, sn;
            { const int fi = lane & 15; const float inv = exp2f(-(float)fi * (13.287712379549449f / 16.0f));
              const float ang = (float)p->pos[t] * inv; double rev = (double)ang * 0.15915494309189535; rev -= floor(rev); const float rv = (float)rev;
              cs = __builtin_amdgcn_cosf(rv); sn = __builtin_amdgcn_sinf(rv); }
            float cj[8], sj[8];
#pragma unroll
            for (int i = 0; i < 8; ++i) { cj[i] = __shfl(cs, 8 * (sub & 1) + i); sj[i] = __shfl(sn, 8 * (sub & 1) + i); }
#pragma unroll
            for (int which = 0; which < 2; ++which) {
                float v[24];
                if (which == 0) {
                    const bf16_t* src = qraw + (size_t)t * 1536 + head * QKH;
#pragma unroll
                    for (int g = 0; g < 3; ++g) { const u32x4 w = *(const u32x4*)(src + 8 * (sub + 4 * g));
#pragma unroll
                        for (int i = 0; i < 4; ++i) { v[8 * g + 2 * i] = bflo(w[i]) * rq; v[8 * g + 2 * i + 1] = bfhi(w[i]) * rq; } }
                } else {
                    const bf16_t* src = kvraw + (size_t)t * 2048 + head * 128;
#pragma unroll
                    for (int g = 0; g < 2; ++g) { const u32x4 w = *(const u32x4*)(src + 8 * (sub + 4 * g));
#pragma unroll
                        for (int i = 0; i < 4; ++i) { v[8 * g + 2 * i] = bflo(w[i]) * rkv; v[8 * g + 2 * i + 1] = bfhi(w[i]) * rkv; } }
                    const u32x4 w = *(const u32x4*)(aout + (size_t)t * ADIMP + QL + KVL + 8 * sub);
#pragma unroll
                    for (int i = 0; i < 4; ++i) { v[16 + 2 * i] = bflo(w[i]); v[16 + 2 * i + 1] = bfhi(w[i]); }
                }
                float ss = 0.f;
#pragma unroll
                for (int i = 0; i < 24; ++i) ss += v[i] * v[i];
                ss += __shfl_xor(ss, 1); ss += __shfl_xor(ss, 2);
                const float rs = rsqrtf(ss * (1.0f / QKH) + EPS);
                const float* gn = which == 0 ? qg : kg;
#pragma unroll
                for (int g = 0; g < 3; ++g) { const f32x4 g0 = *(const f32x4*)(gn + 8 * (sub + 4 * g)), g1 = *(const f32x4*)(gn + 8 * (sub + 4 * g) + 4);
#pragma unroll
                    for (int i = 0; i < 4; ++i) { v[8 * g + i] *= rs * g0[i]; v[8 * g + 4 + i] *= rs * g1[i]; } }
#pragma unroll
                for (int i = 0; i < 8; ++i) { const float mine = v[16 + i], other = __shfl_xor(mine, 2);
                    v[16 + i] = (sub < 2) ? (mine * cj[i] - other * sj[i]) : (other * sj[i] + mine * cj[i]); }
                const float osc = which == 0 ? QSCALE : 1.0f;
                bf16_t* dst = (which == 0 ? Qb : Kb) + ((size_t)t * HEADS + head) * QKH;
#pragma unroll
                for (int g = 0; g < 3; ++g) { u32x4 w;
#pragma unroll
                    for (int i = 0; i < 4; ++i) w[i] = pk2(v[8 * g + 2 * i] * osc, v[8 * g + 2 * i + 1] * osc);
                    *(u32x4*)(dst + 8 * (sub + 4 * g)) = w; }
            }
            { const bf16_t* src = kvraw + (size_t)t * 2048 + head * 128 + 64 + 16 * sub;
#pragma unroll
              for (int g = 0; g < 2; ++g) { const u32x4 w = *(const u32x4*)(src + 8 * g);
#pragma unroll
                  for (int i = 0; i < 4; ++i) { const int d = head * 64 + 16 * sub + 8 * g + 2 * i;
                      *(LAS bf16_t*)(lds + ((d) * VTP + tok) * 2) = f2bf(bflo(w[i]) * rkv);
                      *(LAS bf16_t*)(lds + ((d + 1) * VTP + tok) * 2) = f2bf(bfhi(w[i]) * rkv); } } }
        }
        __syncthreads();
#pragma unroll
        for (int k = 0; k < 8; ++k) { const int id = tid + 512 * k, row = id >> 2, ch = id & 3;
            const u32x4 w = *(const LAS u32x4*)(lds + (row * VTP + ch * 8) * 2);
            *(u32x4*)(Vt + ((size_t)b * 1024 + row) * SEQ + s0 + ch * 8) = w; }
        __syncthreads();
    }
}

DI void attn_phase(PPtr p, int j, ldsp lds, int tid, int wave, int lane) {
    const bf16_t* Qb = (const bf16_t*)(p->ws + WS_QB); const bf16_t* Kb = (const bf16_t*)(p->ws + WS_KB); const bf16_t* Vt = (const bf16_t*)(p->ws + WS_VT);
    bf16_t* O = (bf16_t*)(p->ws + WS_O);
    constexpr int KP = 104, VP = 68, KBYTES = 64 * KP * 2, VBYTES = 64 * VP * 2, BUF = KBYTES + VBYTES;
    const int r = lane & 31, hi = lane >> 5;
    const int k1row = tid / 12, k1ch = tid % 12, k2row = (tid + 512) / 12, k2ch = (tid + 512) % 12, vrow = tid >> 3, vch = tid & 7;
    float mfix;
    { float gq = fabsf(p->mla_q_gain[j * QKH + lane]), gk = fabsf(p->mla_k_gain[j * QKH + lane]);
      if (lane < 32) { gq = fmaxf(gq, fabsf(p->mla_q_gain[j * QKH + 64 + lane])); gk = fmaxf(gk, fabsf(p->mla_k_gain[j * QKH + 64 + lane])); }
#pragma unroll
      for (int o = 1; o < 64; o <<= 1) { gq = fmaxf(gq, __shfl_xor(gq, o)); gk = fmaxf(gk, __shfl_xor(gk, o)); }
      mfix = QSCALE * 96.0f * gq * gk; }
    for (int item = blockIdx.x; item < 512; item += gridDim.x) {
        const int bh = item >> 3, jj = item & 7, b = bh >> 4, hd = bh & 15;
        const bf16_t* kbase = Kb + ((size_t)b * SEQ * HEADS + hd) * QKH;
        const bf16_t* vbase = Vt + ((size_t)(b * HEADS + hd) * 64) * SEQ;
        for (int half = 0; half < 2; ++half) {
            const int qb = half ? 15 - jj : jj, q0 = qb * 256, nt = 4 * qb + 4;
            const int qrow = q0 + 32 * wave + r;
            bf16x8 qf[6];
            { const bf16_t* qp = Qb + ((size_t)(b * SEQ + qrow) * HEADS + hd) * QKH + 8 * hi;
#pragma unroll
              for (int ks = 0; ks < 6; ++ks) qf[ks] = *(const bf16x8*)(qp + 16 * ks); }
            f32x16 o0, o1;
#pragma unroll
            for (int i = 0; i < 16; ++i) { o0[i] = 0.f; o1[i] = 0.f; }
            float lrun = 0.f;
            u32x4 kr1, kr2 = {0u, 0u, 0u, 0u}, vr;
#define ATT_LOAD(kt) do { kr1 = *(const u32x4*)(kbase + (size_t)(64 * (kt) + k1row) * (HEADS * QKH) + k1ch * 8); \
                if (tid < 256) kr2 = *(const u32x4*)(kbase + (size_t)(64 * (kt) + k2row) * (HEADS * QKH) + k2ch * 8); \
                vr = *(const u32x4*)(vbase + (size_t)vrow * SEQ + 64 * (kt) + vch * 8); } while (0)
#define ATT_STORE(bf) do { *(LAS u32x4*)(lds + (bf) * BUF + (k1row * KP + k1ch * 8) * 2) = kr1; \
                if (tid < 256) *(LAS u32x4*)(lds + (bf) * BUF + (k2row * KP + k2ch * 8) * 2) = kr2; \
                *(LAS u32x2*)(lds + (bf) * BUF + KBYTES + (vrow * VP + vch * 8) * 2) = (u32x2){vr[0], vr[1]}; \
                *(LAS u32x2*)(lds + (bf) * BUF + KBYTES + (vrow * VP + vch * 8) * 2 + 8) = (u32x2){vr[2], vr[3]}; } while (0)
            ATT_LOAD(0); ATT_STORE(0);
            __syncthreads();
            for (int kt = 0; kt < nt; ++kt) {
                const int buf = kt & 1;
                if (kt + 1 < nt) ATT_LOAD(kt + 1);
                const int k0 = 64 * kt;
                if (k0 <= q0 + 32 * wave + 31) {
                    f32x16 s0, s1;
#pragma unroll
                    for (int i = 0; i < 16; ++i) { s0[i] = -mfix; s1[i] = -mfix; }
                    const ldsp kb0 = lds + buf * BUF + (r * KP + 8 * hi) * 2;
                    bf16x8 ka[6], kc[6];
#pragma unroll
                    for (int ks = 0; ks < 6; ++ks) { ka[ks] = *(const LAS bf16x8*)(kb0 + ks * 32); kc[ks] = *(const LAS bf16x8*)(kb0 + 32 * KP * 2 + ks * 32); }
                    __builtin_amdgcn_sched_barrier(0);
#pragma unroll
                    for (int ks = 0; ks < 6; ++ks) s0 = MFMA32(ka[ks], qf[ks], s0);
#pragma unroll
                    for (int ks = 0; ks < 6; ++ks) s1 = MFMA32(kc[ks], qf[ks], s1);
                    const ldsp vb0 = lds + buf * BUF + KBYTES + (r * VP + 4 * hi) * 2;
                    s16x4 vlo0[4], vhi0[4], vlo1[4], vhi1[4];
#pragma unroll
                    for (int q = 0; q < 4; ++q) { const ldsp va = vb0 + (16 * q) * 2;
                        vlo0[q] = *(const LAS s16x4*)(va); vhi0[q] = *(const LAS s16x4*)(va + 16);
                        vlo1[q] = *(const LAS s16x4*)(va + 32 * VP * 2); vhi1[q] = *(const LAS s16x4*)(va + 32 * VP * 2 + 16); }
                    const bool diag = (k0 + 63 > q0 + 32 * wave);
                    float psum = 0.f;
                    if (diag) {
#pragma unroll
                        for (int i = 0; i < 16; ++i) { const int key = k0 + crow(i, hi); if (key > qrow) s0[i] = -INFINITY; }
                    }
#pragma unroll
                    for (int i = 0; i < 16; ++i) { s0[i] = __builtin_amdgcn_exp2f(s0[i]); psum += s0[i]; }
#pragma unroll
                    for (int q = 0; q < 2; ++q) { const bf16x8 pf = pack8(s0, q);
                        const bf16x8 vf0 = __builtin_shufflevector(vlo0[q], vhi0[q], 0, 1, 2, 3, 4, 5, 6, 7), vf1 = __builtin_shufflevector(vlo1[q], vhi1[q], 0, 1, 2, 3, 4, 5, 6, 7);
                        o0 = MFMA32(vf0, pf, o0); o1 = MFMA32(vf1, pf, o1); }
                    if (diag) {
#pragma unroll
                        for (int i = 0; i < 16; ++i) { const int key = k0 + 32 + crow(i, hi); if (key > qrow) s1[i] = -INFINITY; }
                    }
#pragma unroll
                    for (int i = 0; i < 16; ++i) { s1[i] = __builtin_amdgcn_exp2f(s1[i]); psum += s1[i]; }
                    lrun += psum;
#pragma unroll
                    for (int q = 2; q < 4; ++q) { const bf16x8 pf = pack8(s1, q & 1);
                        const bf16x8 vf0 = __builtin_shufflevector(vlo0[q], vhi0[q], 0, 1, 2, 3, 4, 5, 6, 7), vf1 = __builtin_shufflevector(vlo1[q], vhi1[q], 0, 1, 2, 3, 4, 5, 6, 7);
                        o0 = MFMA32(vf0, pf, o0); o1 = MFMA32(vf1, pf, o1); }
                }
                if (kt + 1 < nt) ATT_STORE(buf ^ 1);
                __syncthreads();
            }
#undef ATT_LOAD
#undef ATT_STORE
            const float inv = 1.0f / (lrun + __shfl_xor(lrun, 32));
            bf16_t* op = O + (size_t)(b * SEQ + qrow) * DM + hd * 64 + 4 * hi;
#pragma unroll
            for (int g = 0; g < 4; ++g) {
                u32x2 w0, w1; w0.x = pk2(o0[4 * g] * inv, o0[4 * g + 1] * inv); w0.y = pk2(o0[4 * g + 2] * inv, o0[4 * g + 3] * inv);
                w1.x = pk2(o1[4 * g] * inv, o1[4 * g + 1] * inv); w1.y = pk2(o1[4 * g + 2] * inv, o1[4 * g + 3] * inv);
                *(u32x2*)(op + 8 * g) = w0; *(u32x2*)(op + 32 + 8 * g) = w1; }
        }
    }
}

DI void conv_phase(PPtr p, int j, ldsp lds, int tid) {
    const bf16_t* zx = (const bf16_t*)(p->ws + WS_ZX);
    bf16_t* xT = (bf16_t*)(p->ws + WS_XT); bf16_t* Bc = (bf16_t*)(p->ws + WS_BC); bf16_t* Cc = (bf16_t*)(p->ws + WS_CC); bf16_t* BT = (bf16_t*)(p->ws + WS_BT);
    const float* cw = p->ssd_conv_w + (size_t)j * 4 * CONVD; const float* cbias = p->ssd_conv_b + (size_t)j * CONVD;
    constexpr int TPB = 140;
    {
        const int lane = tid & 63, wave = tid >> 6, r = lane & 31, hi = lane >> 5, kq = wave & 3;
        const bf16_t* hb = (const bf16_t*)(p->ws + WS_H); const bf16_t* wdt = (const bf16_t*)(p->ws + WS_WIN + (size_t)j * SZ_WIN) + (size_t)ZXW * DM;
        float* dtraw = (float*)(p->ws + WS_DTRAW);
        for (int base = blockIdx.x * 2; base < T / 32; base += gridDim.x * 2) {
            const int rt = base + (wave >> 2);
            const bf16_t* ap = hb + (size_t)(rt * 32 + r) * DM + kq * 256 + 8 * hi; const bf16_t* bp = wdt + (size_t)r * DM + kq * 256 + 8 * hi;
            f32x16 d0, d1;
#pragma unroll
            for (int i = 0; i < 16; ++i) { d0[i] = 0.f; d1[i] = 0.f; }
            bf16x8 fa[16], fb[16];
#pragma unroll
            for (int ks = 0; ks < 16; ++ks) { fa[ks] = *(const bf16x8*)(ap + ks * 16); fb[ks] = *(const bf16x8*)(bp + ks * 16); }
#pragma unroll
            for (int ks = 0; ks < 16; ks += 2) { d0 = MFMA32(fa[ks], fb[ks], d0); d1 = MFMA32(fa[ks + 1], fb[ks + 1], d1); }
#pragma unroll
            for (int i = 0; i < 16; ++i) *(LAS float*)(lds + ((wave * 16 + i) * 64 + lane) * 4) = d0[i] + d1[i];
            __syncthreads();
            if (kq == 0) {
                float* op = dtraw + (size_t)(rt * 32) * 32 + r;
#pragma unroll
                for (int i = 0; i < 16; ++i) { float v = 0.f;
#pragma unroll
                    for (int q = 0; q < 4; ++q) v += *(const LAS float*)(lds + (((wave + q) * 16 + i) * 64 + lane) * 4);
                    op[(size_t)crow(i, hi) * 32] = v; }
            }
            __syncthreads();
        }
    }
    const int tok = tid >> 3, cgp = tid & 7;
    for (int item = blockIdx.x; item < 256 * 12; item += gridDim.x) {
        const int tt = item / 12, cb = item % 12;
        const int t0 = tt * 64, b = t0 >> 12, s0 = t0 & 4095;
        const int t = t0 + tok, s = s0 + tok;
        u32x4 u[4][4];
#pragma unroll
        for (int k = 0; k < 4; ++k)
#pragma unroll
            for (int w = 0; w < 4; ++w) {
                const int ch0 = cb * 256 + (cgp + 8 * k) * 8;
                if (s - 3 + w >= 0) u[k][w] = *(const u32x4*)(zx + (size_t)(t - 3 + w) * ZXW + DIN + ch0);
                else u[k][w] = (u32x4){0u, 0u, 0u, 0u};
            }
#pragma unroll
        for (int k = 0; k < 4; ++k) {
            const int cl = (cgp + 8 * k) * 8, ch0 = cb * 256 + cl;
            float acc[8];
            { const f32x4 b0 = *(const f32x4*)(cbias + ch0), b1 = *(const f32x4*)(cbias + ch0 + 4);
#pragma unroll
              for (int i = 0; i < 4; ++i) { acc[i] = b0[i]; acc[4 + i] = b1[i]; } }
#pragma unroll
            for (int w = 0; w < 4; ++w) {
                const f32x4 w0 = *(const f32x4*)(cw + w * CONVD + ch0), w1 = *(const f32x4*)(cw + w * CONVD + ch0 + 4);
                const u32x4 uu = u[k][w];
                acc[0] += bflo(uu[0]) * w0[0]; acc[1] += bfhi(uu[0]) * w0[1]; acc[2] += bflo(uu[1]) * w0[2]; acc[3] += bfhi(uu[1]) * w0[3];
                acc[4] += bflo(uu[2]) * w1[0]; acc[5] += bfhi(uu[2]) * w1[1]; acc[6] += bflo(uu[3]) * w1[2]; acc[7] += bfhi(uu[3]) * w1[3];
            }
#pragma unroll
            for (int i = 0; i < 8; ++i) acc[i] = silu_f(acc[i]);
            if (cb >= 8) { u32x4 w; w.x = pk2(acc[0], acc[1]); w.y = pk2(acc[2], acc[3]); w.z = pk2(acc[4], acc[5]); w.w = pk2(acc[6], acc[7]);
                bf16_t* dst = (cb < 10) ? Bc + (size_t)t * 512 + (cb - 8) * 256 + cl : Cc + (size_t)t * 512 + (cb - 10) * 256 + cl;
                *(u32x4*)dst = w; }
            if (cb < 10) {
#pragma unroll
                for (int i = 0; i < 8; ++i) *(LAS bf16_t*)(lds + (cl + i) * TPB + tok * 2) = f2bf(acc[i]);
            }
        }
        if (cb < 10) {
            __syncthreads();
#pragma unroll
            for (int k = 0; k < 4; ++k) { const int id = tid + 512 * k, row = id >> 3, ch = id & 7;
                const ldsp src = lds + row * TPB + ch * 16;
                u32x4 w; w.x = *(const LAS unsigned*)(src); w.y = *(const LAS unsigned*)(src + 4); w.z = *(const LAS unsigned*)(src + 8); w.w = *(const LAS unsigned*)(src + 12);
                bf16_t* dst = (cb < 8) ? xT + ((size_t)b * 2048 + cb * 256 + row) * SEQ + s0 + ch * 8 : BT + ((size_t)b * 512 + (cb - 8) * 256 + row) * SEQ + s0 + ch * 8;
                *(u32x4*)dst = w; }
            __syncthreads();
        }
    }
}

DI void scan_phase(PPtr p, int j, ldsp lds, int tid, int wave, int lane) {
    const bf16_t* xT = (const bf16_t*)(p->ws + WS_XT); const bf16_t* Bc = (const bf16_t*)(p->ws + WS_BC); const bf16_t* Cc = (const bf16_t*)(p->ws + WS_CC);
    const bf16_t* BT = (const bf16_t*)(p->ws + WS_BT); const float* dtraw = (const float*)(p->ws + WS_DTRAW); bf16_t* Y = (bf16_t*)(p->ws + WS_Y);
    constexpr int PT = 136, PB = PT * 2;
    constexpr int O_C = 0, O_B = 128 * PB, O_BT = 2 * 128 * PB, O_X = 3 * 128 * PB, O_XW = O_X + 32 * PB, O_S = O_XW + 32 * PB, O_DT = O_S + 32 * PB, O_AC = O_DT + 8 * 512;
    LAS float* s_dt = (LAS float*)(lds + O_DT + wave * 512); LAS float* s_ac = (LAS float*)(lds + O_AC + wave * 512);
    const int r = lane & 31, hi = lane >> 5;
    for (int unit0 = blockIdx.x; unit0 < 256; unit0 += gridDim.x) {
        const int unit = (gridDim.x == 256) ? ((unit0 & 7) * 32 + (unit0 >> 3)) : unit0;
        const int b = unit >> 6, h = (unit >> 1) & 31, ph = unit & 1, g = h >> 3;
        const float A = -__expf(p->ssd_a_log[j * SSDH + h]); const float dtb = p->ssd_dt_bias[j * SSDH + h]; const float Dh = p->ssd_d[j * SSDH + h];
        f32x16 accS;
#pragma unroll
        for (int i = 0; i < 16; ++i) accS[i] = 0.f;
        for (int i = tid; i < 32 * PB / 4; i += 512) *(LAS unsigned*)(lds + O_S + i * 4) = 0u;
        u32x4 rc[4], rb[4], rbt[4], rx; float dr0, dr1;
        const unsigned offRow = (unsigned)((tid >> 4) * 512 + (tid & 15) * 8), offT = (unsigned)((tid >> 4) * SEQ + (tid & 15) * 8);
        const bf16_t* cBase = Cc + (size_t)b * SEQ * 512 + g * 128; const bf16_t* bBase = Bc + (size_t)b * SEQ * 512 + g * 128;
        const bf16_t* btBase = BT + ((size_t)b * 512 + g * 128) * SEQ; const bf16_t* xBase = xT + ((size_t)b * 2048 + h * 64 + ph * 32) * SEQ;
        const float* dBase = dtraw + (size_t)b * SEQ * 32 + h;
#define SCAN_LOAD(c) do { const bf16_t* c_ = cBase + (size_t)(c) * 128 * 512; const bf16_t* b_ = bBase + (size_t)(c) * 128 * 512; const bf16_t* bt_ = btBase + (c) * 128; \
            _Pragma("unroll") for (int k = 0; k < 4; ++k) { \
                rc[k] = *(const u32x4*)(c_ + (offRow + (unsigned)(k * 32 * 512))); \
                rb[k] = *(const u32x4*)(b_ + (offRow + (unsigned)(k * 32 * 512))); \
                rbt[k] = *(const u32x4*)(bt_ + (offT + (unsigned)(k * 32 * SEQ))); } \
            rx = *(const u32x4*)(xBase + (c) * 128 + offT); \
            dr0 = dBase[(unsigned)(((c) * 128 + lane) * 32)]; dr1 = dBase[(unsigned)(((c) * 128 + lane + 64) * 32)]; } while (0)
        SCAN_LOAD(0);
        for (int c = 0; c < 32; ++c) {
            const int t0 = b * SEQ + c * 128;
            {
                const float x0 = dr0 + dtb, x1 = dr1 + dtb;
                const float d0 = x0 > 20.f ? x0 : log1pf(__expf(x0)), d1 = x1 > 20.f ? x1 : log1pf(__expf(x1));
                float v0 = d0 * A * 1.4426950408889634f, v1 = d1 * A * 1.4426950408889634f;
#pragma unroll
                for (int off = 1; off < 64; off <<= 1) { const float n0 = __shfl_up(v0, off), n1 = __shfl_up(v1, off); if (lane >= off) { v0 += n0; v1 += n1; } }
                v1 += __shfl(v0, 63);
                s_dt[lane] = d0; s_dt[lane + 64] = d1; s_ac[lane] = v0; s_ac[lane + 64] = v1;
            }
#pragma unroll
            for (int k = 0; k < 4; ++k) { const int id = tid + 512 * k, row = id >> 4, ch = id & 15; const int off = (row * PT + ch * 8) * 2;
                *(LAS u32x4*)(lds + O_C + off) = rc[k]; *(LAS u32x4*)(lds + O_B + off) = rb[k]; *(LAS u32x4*)(lds + O_BT + off) = rbt[k]; }
            { const int row = tid >> 4, ch = tid & 15; const int off = (row * PT + ch * 8) * 2;
              const float aend = s_ac[127]; u32x4 w, wd;
              const f32x4 da = *(const LAS f32x4*)(s_dt + ch * 8), db = *(const LAS f32x4*)(s_dt + ch * 8 + 4), aa = *(const LAS f32x4*)(s_ac + ch * 8), ab = *(const LAS f32x4*)(s_ac + ch * 8 + 4);
              float xd[8];
              xd[0] = bflo(rx[0]) * da[0]; xd[1] = bfhi(rx[0]) * da[1]; xd[2] = bflo(rx[1]) * da[2]; xd[3] = bfhi(rx[1]) * da[3];
              xd[4] = bflo(rx[2]) * db[0]; xd[5] = bfhi(rx[2]) * db[1]; xd[6] = bflo(rx[3]) * db[2]; xd[7] = bfhi(rx[3]) * db[3];
              wd[0] = pk2(xd[0], xd[1]); wd[1] = pk2(xd[2], xd[3]); wd[2] = pk2(xd[4], xd[5]); wd[3] = pk2(xd[6], xd[7]);
              w[0] = pk2(xd[0] * __builtin_amdgcn_exp2f(aend - aa[0]), xd[1] * __builtin_amdgcn_exp2f(aend - aa[1]));
              w[1] = pk2(xd[2] * __builtin_amdgcn_exp2f(aend - aa[2]), xd[3] * __builtin_amdgcn_exp2f(aend - aa[3]));
              w[2] = pk2(xd[4] * __builtin_amdgcn_exp2f(aend - ab[0]), xd[5] * __builtin_amdgcn_exp2f(aend - ab[1]));
              w[3] = pk2(xd[6] * __builtin_amdgcn_exp2f(aend - ab[2]), xd[7] * __builtin_amdgcn_exp2f(aend - ab[3]));
              *(LAS u32x4*)(lds + O_X + off) = wd;
              *(LAS u32x4*)(lds + O_XW + off) = w; }
            if (c + 1 < 32) SCAN_LOAD(c + 1);
            LDS_BARRIER();
#define SCAN_BLOCK(YACC, sb, DIAG) do { \
                    f32x16 cb; \
                    _Pragma("unroll") for (int i = 0; i < 16; ++i) cb[i] = 0.f; \
                    _Pragma("unroll") for (int kh = 0; kh < 2; ++kh) { \
                        _Pragma("unroll") for (int ks = 0; ks < 4; ++ks) { fa[ks] = *(const LAS bf16x8*)(lds + O_B + ((32 * (sb) + r) * PT + 16 * (4 * kh + ks) + 8 * hi) * 2); \
                            fc[ks] = *(const LAS bf16x8*)(lds + O_C + (l * PT + 16 * (4 * kh + ks) + 8 * hi) * 2); } \
                        __builtin_amdgcn_sched_barrier(0); \
                        _Pragma("unroll") for (int ks = 0; ks < 4; ++ks) cb = MFMA32(fa[ks], fc[ks], cb); \
                    } \
                    _Pragma("unroll") for (int gq = 0; gq < 4; ++gq) { \
                        const int sbase = 32 * (sb) + 8 * gq + 4 * hi; \
                        const f32x4 acs = *(const LAS f32x4*)(s_ac + sbase); \
                        _Pragma("unroll") for (int q = 0; q < 4; ++q) { \
                            float v = cb[4 * gq + q] * __builtin_amdgcn_exp2f(acl - acs[q]); \
                            if (DIAG) { const int sidx = sbase + q; v = (sidx <= l) ? v : 0.f; if (sidx == l) v += dskip; } \
                            cb[4 * gq + q] = v; } \
                    } \
                    _Pragma("unroll") for (int ks2 = 0; ks2 < 2; ++ks2) { \
                        const bf16x8 pf = pack8(cb, ks2); \
                        const ldsp xa = lds + O_X + (r * PT + 32 * (sb) + 16 * ks2 + 4 * hi) * 2; \
                        const s16x4 lo = *(const LAS s16x4*)(xa), hh = *(const LAS s16x4*)(xa + 16); \
                        const bf16x8 xf = __builtin_shufflevector(lo, hh, 0, 1, 2, 3, 4, 5, 6, 7); \
                        YACC = MFMA32(xf, pf, YACC); } \
                } while (0)
            constexpr int O_PART = O_AC + 8 * 512;
            f32x16 ya;
#pragma unroll
            for (int i = 0; i < 16; ++i) ya[i] = 0.f;
            if (wave < 4) {
                const int lb = wave, l = 32 * lb + r; const float acl = s_ac[l];
                bf16x8 fa[4], fc[4];
#pragma unroll
                for (int kh = 0; kh < 2; ++kh) {
#pragma unroll
                    for (int ks = 0; ks < 4; ++ks) { fa[ks] = *(const LAS bf16x8*)(lds + O_S + (r * PT + 16 * (4 * kh + ks) + 8 * hi) * 2);
                        fc[ks] = *(const LAS bf16x8*)(lds + O_C + (l * PT + 16 * (4 * kh + ks) + 8 * hi) * 2); }
                    __builtin_amdgcn_sched_barrier(0);
#pragma unroll
                    for (int ks = 0; ks < 4; ++ks) ya = MFMA32(fa[ks], fc[ks], ya);
                }
                { const float e = __builtin_amdgcn_exp2f(acl);
#pragma unroll
                  for (int i = 0; i < 16; ++i) ya[i] *= e; }
                const float dskip = Dh * __builtin_amdgcn_rcpf(s_dt[l]);
                if (lb >= 1) SCAN_BLOCK(ya, lb - 1, false);
                SCAN_BLOCK(ya, lb, true);
            } else {
                const int nb = wave - 4; const float dec = __builtin_amdgcn_exp2f(s_ac[127]);
                {
#pragma unroll
                    for (int i = 0; i < 16; ++i) accS[i] *= dec;
#pragma unroll
                    for (int kh = 0; kh < 2; ++kh) {
                        bf16x8 fa[4], fb[4];
#pragma unroll
                        for (int ks = 0; ks < 4; ++ks) { fa[ks] = *(const LAS bf16x8*)(lds + O_XW + (r * PT + 16 * (4 * kh + ks) + 8 * hi) * 2);
                            fb[ks] = *(const LAS bf16x8*)(lds + O_BT + ((32 * nb + r) * PT + 16 * (4 * kh + ks) + 8 * hi) * 2); }
                        __builtin_amdgcn_sched_barrier(0);
#pragma unroll
                        for (int ks = 0; ks < 4; ++ks) accS = MFMA32(fa[ks], fb[ks], accS);
                    }
                }
                if (nb >= 2) {
                    const int l = 32 * nb + r; const float acl = s_ac[l]; const float dskip = 0.f; (void)dskip;
                    bf16x8 fa[4], fc[4];
                    for (int sb = 0; sb <= nb - 2; ++sb) SCAN_BLOCK(ya, sb, false);
#pragma unroll
                    for (int i = 0; i < 16; ++i) *(LAS float*)(lds + O_PART + (((nb - 2) * 16 + i) * 64 + lane) * 4) = ya[i];
                }
            }
#undef SCAN_BLOCK
            LDS_BARRIER();
            if (wave < 4) {
                const int lb = wave, l = 32 * lb + r;
                if (lb >= 2) {
#pragma unroll
                    for (int i = 0; i < 16; ++i) ya[i] += *(const LAS float*)(lds + O_PART + (((lb - 2) * 16 + i) * 64 + lane) * 4);
                }
                bf16_t* yp = Y + (size_t)(t0 + l) * DIN + h * 64 + ph * 32 + 4 * hi;
#pragma unroll
                for (int gq = 0; gq < 4; ++gq) { u32x2 w; w.x = pk2(ya[4 * gq], ya[4 * gq + 1]); w.y = pk2(ya[4 * gq + 2], ya[4 * gq + 3]); *(u32x2*)(yp + 8 * gq) = w; }
            } else { const int nb = wave - 4;
#pragma unroll
                for (int i = 0; i < 16; ++i) *(LAS bf16_t*)(lds + O_S + (crow(i, hi) * PT + 32 * nb + r) * 2) = f2bf(accS[i]); }
        }
#undef SCAN_LOAD
        __syncthreads();
    }
}

DI void gatenorm_phase(PPtr p, int wave, int lane) {
    const bf16_t* zx = (const bf16_t*)(p->ws + WS_ZX); const bf16_t* Y = (const bf16_t*)(p->ws + WS_Y); bf16_t* gn = (bf16_t*)(p->ws + WS_GN);
    const int gw = blockIdx.x * 8 + wave, ngw = gridDim.x * 8;
    for (int t0 = gw * 2; t0 < T; t0 += ngw * 2) {
        u32x4 yv[2][4], zv[2][4];
#pragma unroll
        for (int rr = 0; rr < 2; ++rr)
#pragma unroll
            for (int jg = 0; jg < 4; ++jg) { const int c = 8 * (lane + 64 * jg);
                yv[rr][jg] = *(const u32x4*)(Y + (size_t)(t0 + rr) * DIN + c); zv[rr][jg] = *(const u32x4*)(zx + (size_t)(t0 + rr) * ZXW + c); }
#pragma unroll
        for (int rr = 0; rr < 2; ++rr)
#pragma unroll
            for (int jg = 0; jg < 4; ++jg) {
                const int c = 8 * (lane + 64 * jg);
                float v[8]; float ss = 0.f;
#pragma unroll
                for (int i = 0; i < 4; ++i) { v[2 * i] = bflo(yv[rr][jg][i]) * silu_f(bflo(zv[rr][jg][i])); v[2 * i + 1] = bfhi(yv[rr][jg][i]) * silu_f(bfhi(zv[rr][jg][i])); ss += v[2 * i] * v[2 * i] + v[2 * i + 1] * v[2 * i + 1]; }
                const float rs = rsqrtf(wave_sum(ss) * (1.0f / 512.0f) + EPS);
                u32x4 w;
#pragma unroll
                for (int i = 0; i < 4; ++i) w[i] = pk2(v[2 * i] * rs, v[2 * i + 1] * rs);
                *(u32x4*)(gn + (size_t)(t0 + rr) * DIN + c) = w;
            }
    }
}

#define XB_TMO      128
#define XB_XCNT(j)  (256  + 64 * (j))
#define XB_XSUB(j)  (1280 + 64 * (j))
#define XB_XGEN(j)  (2304 + 64 * (j))
#define XB_TOP      3328
#define XB_TOPGEN   3392
#define XCD_BAR_WORDS 3456
#define XB_SPIN_CAP (1u << 22)
DI unsigned xb_ld(unsigned* p)              { return __hip_atomic_load(p, __ATOMIC_RELAXED, __HIP_MEMORY_SCOPE_AGENT); }
DI unsigned xb_add(unsigned* p, unsigned v) { return __hip_atomic_fetch_add(p, v, __ATOMIC_RELAXED, __HIP_MEMORY_SCOPE_AGENT); }
DI unsigned xb_xcc_id() { return (unsigned)__builtin_amdgcn_s_getreg((3 << 11) | 20) & 0xFu; }
#define XB_SPIN(cond, bar) do { unsigned _sp = 0; while (cond) { __builtin_amdgcn_s_sleep(1); \
    if ((++_sp & 255u) == 0u) { if (xb_ld(&(bar)[XB_TMO])) break; if (_sp > XB_SPIN_CAP) { atomicAdd(&(bar)[XB_TMO], 1u); break; } } } } while (0)
struct XcdBarrier { unsigned* bar; unsigned x; volatile LAS unsigned* st; };
DI XcdBarrier xcd_barrier_post(unsigned* bar, volatile LAS unsigned* st) {
    XcdBarrier b; b.bar = bar; b.x = xb_xcc_id(); b.st = st;
    if (threadIdx.x == 0) (void)xb_add(&bar[XB_XCNT(b.x)], 1u);
    return b;
}
DI void xcd_barrier_complete(unsigned* bar, unsigned x, unsigned& nloc, unsigned& nx) {
    const unsigned G = gridDim.x * gridDim.y * gridDim.z;
    unsigned sum, cnt, mine, sp = 0u;
    for (;;) {
        sum = 0u; cnt = 0u; mine = 0u;
#pragma unroll
        for (unsigned j = 0; j < 16; ++j) { const unsigned c = xb_ld(&bar[XB_XCNT(j)]); sum += c; cnt += (c > 0u) ? 1u : 0u; mine = (j == x) ? c : mine; }
        if (sum == G) break;
        __builtin_amdgcn_s_sleep(1);
        if ((++sp & 255u) == 0u) { if (xb_ld(&bar[XB_TMO])) break; if (sp > XB_SPIN_CAP) { atomicAdd(&bar[XB_TMO], 1u); break; } }
    }
    nloc = mine > 0u ? mine : 1u; nx = cnt > 0u ? cnt : 1u;
}
DI void xcd_barrier(unsigned* bar_, volatile LAS unsigned* st_) {
    XcdBarrier b; b.bar = bar_; b.st = st_; b.x = 0;
    asm volatile("s_waitcnt vmcnt(0)" ::: "memory");
    __syncthreads();
    if (threadIdx.x == 0) {
        unsigned* bar = b.bar; b.x = xb_xcc_id();
        __builtin_amdgcn_s_waitcnt(0);
        unsigned nloc = b.st[0], nx = b.st[1];
        if (nloc == 0u) { xcd_barrier_complete(bar, b.x, nloc, nx); b.st[0] = nloc; b.st[1] = nx; }
        const unsigned old = xb_add(&bar[XB_XSUB(b.x)], 1u);
        const unsigned gen = old / nloc;
        if (old + 1u == (gen + 1u) * nloc) {
            __builtin_amdgcn_fence(__ATOMIC_RELEASE, "agent");
            asm volatile("s_waitcnt vmcnt(0)" ::: "memory");
            const unsigned og = xb_add(&bar[XB_TOP], 1u);
            const unsigned tg = og / nx;
            if (og + 1u == (tg + 1u) * nx) xb_add(&bar[XB_TOPGEN], 1u);
            else XB_SPIN(xb_ld(&bar[XB_TOPGEN]) == tg, bar);
            __builtin_amdgcn_fence(__ATOMIC_ACQUIRE, "agent");
            xb_add(&bar[XB_XGEN(b.x)], 1u);
            asm volatile("s_waitcnt vmcnt(0)" ::: "memory");
        } else {
            XB_SPIN(xb_ld(&bar[XB_XGEN(b.x)]) == gen, bar);
            __builtin_amdgcn_fence(__ATOMIC_ACQUIRE, "agent");
            asm volatile("s_waitcnt vmcnt(0)" ::: "memory");
        }
    }
    __syncthreads();
}

DI void grp_barrier(unsigned* ctl, volatile LAS unsigned* st) {
    asm volatile("s_waitcnt vmcnt(0)" ::: "memory");
    __syncthreads();
    if (threadIdx.x == 0) {
        const unsigned g = blockIdx.x & 7u, nmemb = gridDim.x >> 3;
        unsigned same = st[4];
        if (same == 0u) { same = (xb_ld(ctl + 12288 + g * 16 + xb_xcc_id()) == nmemb) ? 1u : 2u; st[4] = same; }
        unsigned* cnt = ctl + 8192 + 64 * g; unsigned* genw = ctl + 8192 + 64 * (8 + g);
        if (same != 1u) { __builtin_amdgcn_fence(__ATOMIC_RELEASE, "agent"); asm volatile("s_waitcnt vmcnt(0)" ::: "memory"); }
        const unsigned old = xb_add(cnt, 1u), gen = old / nmemb;
        if (old + 1u == (gen + 1u) * nmemb) xb_add(genw, 1u);
        else { unsigned sp = 0; while (xb_ld(genw) == gen && ++sp < (1u << 22)) __builtin_amdgcn_s_sleep(1); }
        __builtin_amdgcn_fence(__ATOMIC_ACQUIRE, "agent");
        asm volatile("s_waitcnt vmcnt(0)" ::: "memory");
    }
    __syncthreads();
}

__global__ void __launch_bounds__(512, 2) mega_fwd(Params pv) {
    extern __shared__ __attribute__((aligned(16))) unsigned char lds_raw[];
    ldsp lds = (ldsp)lds_raw;
    PPtr p = (PPtr)__builtin_amdgcn_kernarg_segment_ptr();
    cg::grid_group grid = cg::this_grid();
    constexpr int BAR_LDS_OFF = LDS_BYTES - 64;
    if (threadIdx.x < 16) ((LAS unsigned*)(lds + BAR_LDS_OFF))[threadIdx.x] = 0u;
    __syncthreads();
    (void)xcd_barrier_post((unsigned*)(p->ws + WS_CTL), (volatile LAS unsigned*)(lds + BAR_LDS_OFF));
    if (threadIdx.x == 0) (void)xb_add((unsigned*)(p->ws + WS_CTL) + 12288 + (blockIdx.x & 7u) * 16 + xb_xcc_id(), 1u);
#define GRID_SYNC() do { FRESH(p); xcd_barrier((unsigned*)(p->ws + WS_CTL), (volatile LAS unsigned*)(lds + BAR_LDS_OFF)); FRESH(p); } while (0)
#define GROUP_SYNC() do { if (gridDim.x == 256) { FRESH(p); grp_barrier((unsigned*)(p->ws + WS_CTL), (volatile LAS unsigned*)(lds + BAR_LDS_OFF)); FRESH(p); } else GRID_SYNC(); } while (0)
#define mods ((const float*)(p->ws + WS_MODS))
#define hbuf ((bf16_t*)(p->ws + WS_H))

    { PHASE_IDS(); phase0(p, lds, tid, wave, lane); }
    if (p->out == nullptr) grid.sync();
    GRID_SYNC();

#pragma unroll 1
    for (int layer = 0; layer < DEPTH; ++layer) {
        const int j = layer >> 1;
#pragma unroll 1
        for (int sub = 0; sub < 3; ++sub) {
            const float* xin = (layer == 0 && sub == 0) ? p->x : p->out;
            const float* mods_ls = mods + (size_t)(layer * 36 + sub * 3) * 1024;
            const int qs = layer * 3 + sub;
            const bool fuse_norm = FUSE_NORM && (gridDim.x == 256);
            if (qs == 0 || !fuse_norm) {
                { PHASE_IDS(); norm_phase(xin, p->norm_gain + (size_t)(layer * 3 + sub) * DM, mods_ls, hbuf, wave, lane); }
                if (sub != 1) GROUP_SYNC(); else GRID_SYNC();
            }
            pg8::Gemm rg; float gs;
            if (sub != 1) {
                const int fi = layer * 2 + (sub == 2 ? 1 : 0);
                pg8::Gemm g{hbuf, (const bf16_t*)(p->ws + WS_WGU + fi * SZ_WGU), T, 2 * DFF, DM, DM};
                pg8::StaticOrder S; S.init(T, 2 * DFF, gridDim.x, opaque_bid());
                pg8::EpiSwiGLU E{(bf16_t*)(p->ws + WS_ACT)};
                REP(1) { pg8::gemm_phase<pg8::EpiSwiGLU>(lds, g, S, E);
                GROUP_SYNC(); }
                rg = pg8::Gemm{(const bf16_t*)(p->ws + WS_ACT), (const bf16_t*)(p->ws + WS_WDN + fi * SZ_WDN), T, DM, DFF, DFF}; gs = 0.5f;
            } else {
                const bool mla = (layer & 1) == 0;
                const int nrounds = mla ? 2 : 1;
#pragma unroll 1
                for (int round = 0; round < nrounds; ++round) REP(32) {
                    const int njobs = (mla && round == 1) ? 2 : 1;
#pragma unroll 1
                    for (int job = 0; job < njobs; ++job) {
                        pg8::Gemm g; pg8::EpiStore E;
                        if (!mla) { g = pg8::Gemm{hbuf, (const bf16_t*)(p->ws + WS_WIN + j * SZ_WIN), T, ZXW, DM, DM}; E = pg8::EpiStore{(bf16_t*)(p->ws + WS_ZX), ZXW, ZXW, nullptr}; }
                        else if (round == 0) { g = pg8::Gemm{hbuf, (const bf16_t*)(p->ws + WS_WA + j * SZ_WA), T, ADIMP, DM, DM}; E = pg8::EpiStore{(bf16_t*)(p->ws + WS_AOUT), ADIMP, ADIMP, nullptr}; }
                        else if (job == 0) { g = pg8::Gemm{(const bf16_t*)(p->ws + WS_AOUT), (const bf16_t*)(p->ws + WS_WQB + j * SZ_WQB), T, 1536, QL, ADIMP}; E = pg8::EpiStore{(bf16_t*)(p->ws + WS_QRAW), 1536, 1536, nullptr}; }
                        else { g = pg8::Gemm{(const bf16_t*)(p->ws + WS_AOUT) + QL, (const bf16_t*)(p->ws + WS_WKVB + j * SZ_WKVB), T, 2048, KVL, ADIMP}; E = pg8::EpiStore{(bf16_t*)(p->ws + WS_KVRAW), 2048, 2048, nullptr}; }
                        pg8::StaticOrder S; S.init(T, g.N, gridDim.x, opaque_bid());
                        pg8::gemm_phase<pg8::EpiStore>(lds, g, S, E);
                    }
                    GRID_SYNC();
                }
                if (mla) {
                    REP(16) { { PHASE_IDS(); mla_finalize(p, j, lds, tid, wave, lane); }
                    GRID_SYNC(); }
                    REP(2) { { PHASE_IDS(); attn_phase(p, j, lds, tid, wave, lane); }
                    GRID_SYNC(); }
                    rg = pg8::Gemm{(const bf16_t*)(p->ws + WS_O), (const bf16_t*)(p->ws + WS_WO + j * SZ_WO), T, DM, DM, DM}; gs = 1.0f;
                } else {
                    REP(16) { { PHASE_IDS(); conv_phase(p, j, lds, tid); }
                    GRID_SYNC(); }
                    REP(4) { { PHASE_IDS(); scan_phase(p, j, lds, tid, wave, lane); }
                    GRID_SYNC(); }
                    REP(16) { { PHASE_IDS(); gatenorm_phase(p, wave, lane); }
                    GRID_SYNC(); }
                    rg = pg8::Gemm{(const bf16_t*)(p->ws + WS_GN), (const bf16_t*)(p->ws + WS_WOUT + j * SZ_WOUT), T, DM, DIN, DIN}; gs = 1.0f;
                }
            }
            {
                pg8::StaticOrder S; S.init(T, DM, gridDim.x, opaque_bid());
                const bool has_next = qs < 11; const int qn = has_next ? qs + 1 : 0, ln = qn / 3, sn = qn % 3;
                pg8::EpiRes E{xin, p->out, mods_ls + 2048, hbuf, p->norm_gain + (size_t)qn * DM, mods + (size_t)(ln * 36 + sn * 3) * 1024,
                              (float*)(p->ws + WS_ROWSS), (unsigned*)(p->ws + WS_CTL) + 8192, gs, (has_next && fuse_norm) ? 1 : 0, 32u * (unsigned)(qs + 1), 0};
                pg8::gemm_phase<pg8::EpiRes>(lds, rg, S, E);
            }
            if (qs < 11) GROUP_SYNC();
        }
    }
}

extern "C" void kernel_launch(void* const* d_in, const int* in_sizes, int n_in, void* d_out, int out_size, void* d_ws, size_t ws_size, hipStream_t stream) {
    static int grid = 0;
    if (grid == 0) {
        if (n_in != 24 || out_size != T * DM || ws_size < WS_END) { fprintf(stderr, "kernel_launch: unexpected shapes (n_in %d, out %d, ws %zu, need %zu)\n", n_in, out_size, ws_size, (size_t)WS_END); grid = -1; return; }
        int dev = 0, cus = 0, per_cu = 0;
        (void)hipGetDevice(&dev);
        (void)hipDeviceGetAttribute(&cus, hipDeviceAttributeMultiprocessorCount, dev);
        (void)hipFuncSetAttribute((const void*)mega_fwd, hipFuncAttributeMaxDynamicSharedMemorySize, LDS_BYTES);
        (void)hipOccupancyMaxActiveBlocksPerMultiprocessor(&per_cu, (const void*)mega_fwd, 512, LDS_BYTES);
        if (per_cu < 1) { fprintf(stderr, "kernel_launch: occupancy query says %d blocks per CU\n", per_cu); per_cu = 1; }
        (void)hipGetLastError();
        grid = cus;
    }
    if (grid < 0) return;
    (void)hipMemsetAsync((unsigned char*)d_ws + WS_CTL, 0, 65536, stream);
    Params hp{};
        hp.x = (const float*)d_in[0]; hp.c = (const float*)d_in[1]; hp.pos = (const int*)d_in[2];
    hp.norm_gain = (const float*)d_in[3]; hp.ada_w = (const float*)d_in[4]; hp.ada_b = (const float*)d_in[5];
    hp.ffn_w_gu = (const float*)d_in[6]; hp.ffn_w_down = (const float*)d_in[7];
    hp.mla_w_a = (const float*)d_in[8]; hp.mla_q_a_gain = (const float*)d_in[9]; hp.mla_kv_a_gain = (const float*)d_in[10];
    hp.mla_w_qb = (const float*)d_in[11]; hp.mla_w_kvb = (const float*)d_in[12]; hp.mla_q_gain = (const float*)d_in[13];
    hp.mla_k_gain = (const float*)d_in[14]; hp.mla_w_o = (const float*)d_in[15];
    hp.ssd_w_in = (const float*)d_in[16]; hp.ssd_conv_w = (const float*)d_in[17]; hp.ssd_conv_b = (const float*)d_in[18];
    hp.ssd_dt_bias = (const float*)d_in[19]; hp.ssd_a_log = (const float*)d_in[20]; hp.ssd_d = (const float*)d_in[21];
    hp.ssd_norm_gain = (const float*)d_in[22]; hp.ssd_w_out = (const float*)d_in[23];
    hp.out = (float*)d_out; hp.ws = (unsigned char*)d_ws;
    void* args[] = {&hp};
    hipError_t e = hipLaunchCooperativeKernel((const void*)mega_fwd, dim3(grid), dim3(512), args, LDS_BYTES, stream);
    if (e != hipSuccess) fprintf(stderr, "kernel_launch: cooperative launch failed: %s (grid %d)\n", hipGetErrorString(e), grid);
}
```
